# Optimizing an MI355X kernel written in HIP

```python
import math
import jax, jax.numpy as jnp
from jax import lax
import numpy as np

D_MODEL = 1024
BATCH = 2
SEQ = 8192
DEPTH = 1

ATTN_WIDTH = D_MODEL // 2
POOL_WIDTH = D_MODEL - ATTN_WIDTH
HEAD_DIM = 64
N_HEADS = ATTN_WIDTH // HEAD_DIM
MOBA_BLOCK = 256
MOBA_TOPK = 3
Q_CHUNK = 32
POOL_WINDOWS = (2, 4, 8, 16)
N_POOL_GROUPS = len(POOL_WINDOWS)
POOL_GROUP = POOL_WIDTH // N_POOL_GROUPS
ROPE_THETA = 10000.0
EPS = 1e-6
IN_WIDTH = 4 * ATTN_WIDTH + 2 * POOL_WIDTH

kernel_name = "hymba_moba_pool_hybrid"


def rmsnorm(x, g):
    xf = x.astype(jnp.float32)
    y = xf * lax.rsqrt(jnp.mean(xf * xf, axis=-1, keepdims=True) + EPS)
    return (y * g.astype(jnp.float32)).astype(x.dtype)


def rope(x, pos):
    dh = x.shape[-1]
    inv_freq = 1.0 / (ROPE_THETA ** (jnp.arange(0, dh, 2, dtype=jnp.float32) / dh))
    ang = pos[:, None] * inv_freq[None, :]
    cos, sin = jnp.cos(ang), jnp.sin(ang)
    xf = x.astype(jnp.float32)
    x1, x2 = xf[..., : dh // 2], xf[..., dh // 2:]
    out = jnp.concatenate([x1 * cos - x2 * sin, x2 * cos + x1 * sin], axis=-1)
    return out.astype(x.dtype)


def moba_attention(q, k, v):
    B, H, S, dh = q.shape
    nb = -(-S // MOBA_BLOCK)
    s_pad = nb * MOBA_BLOCK
    padw = ((0, 0), (0, 0), (0, s_pad - S), (0, 0))
    q, k, v = jnp.pad(q, padw), jnp.pad(k, padw), jnp.pad(v, padw)
    kb = k.reshape(B, H, nb, MOBA_BLOCK, dh)
    vb = v.reshape(B, H, nb, MOBA_BLOCK, dh)
    k_mean = jnp.mean(kb.astype(jnp.float32), axis=3)
    n_chunks = s_pad // Q_CHUNK
    qc = jnp.transpose(q.reshape(B, H, n_chunks, Q_CHUNK, dh), (2, 0, 1, 3, 4))
    k_sel = min(MOBA_TOPK, nb)
    scale = HEAD_DIM ** -0.5
    bi = jnp.arange(B)[:, None, None, None]
    hi = jnp.arange(H)[None, :, None, None]
    blk_ids = jnp.arange(nb)
    own_off = jnp.arange(MOBA_BLOCK)

    def step(args):
        c, qi = args
        q_start = c * Q_CHUNK
        qpos = q_start + jnp.arange(Q_CHUNK)
        blk = q_start // MOBA_BLOCK
        qf = qi.astype(jnp.float32)
        gate = jnp.einsum('bhqd,bhnd->bhqn', qf, k_mean)
        gate = jnp.where(blk_ids[None, None, None, :] < blk, gate, -jnp.inf)
        _, top_idx = lax.top_k(gate, k_sel)
        sel_valid = top_idx < blk
        ks = kb[bi, hi, top_idx]
        vs = vb[bi, hi, top_idx]
        s_sel = jnp.einsum('bhqd,bhqkjd->bhqkj', qf, ks.astype(jnp.float32)) * scale
        s_sel = jnp.where(sel_valid[..., None], s_sel, -jnp.inf)
        s_sel = s_sel.reshape(B, H, Q_CHUNK, k_sel * MOBA_BLOCK)
        k_own = lax.dynamic_index_in_dim(kb, blk, axis=2, keepdims=False)
        v_own = lax.dynamic_index_in_dim(vb, blk, axis=2, keepdims=False)
        kpos = blk * MOBA_BLOCK + own_off
        s_own = jnp.einsum('bhqd,bhjd->bhqj', qf, k_own.astype(jnp.float32)) * scale
        s_own = jnp.where(kpos[None, :] <= qpos[:, None], s_own, -jnp.inf)
        p = jax.nn.softmax(jnp.concatenate([s_sel, s_own], axis=-1), axis=-1)
        p_sel = p[..., : k_sel * MOBA_BLOCK].reshape(B, H, Q_CHUNK, k_sel, MOBA_BLOCK)
        p_own = p[..., k_sel * MOBA_BLOCK:]
        out = (jnp.einsum('bhqkj,bhqkjd->bhqd', p_sel, vs.astype(jnp.float32))
               + jnp.einsum('bhqj,bhjd->bhqd', p_own, v_own.astype(jnp.float32)))
        return out.astype(qi.dtype)

    outs = lax.map(step, (jnp.arange(n_chunks), qc))
    out = jnp.transpose(outs, (1, 2, 0, 3, 4)).reshape(B, H, s_pad, dh)
    return out[:, :, :S]


def causal_pool_minus_identity(u, window):
    S = u.shape[1]
    cs = jnp.cumsum(u.astype(jnp.float32), axis=1)
    cs_prev = jnp.pad(cs, ((0, 0), (window, 0), (0, 0)))[:, :S]
    count = jnp.minimum(jnp.arange(1, S + 1), window).astype(jnp.float32)[None, :, None]
    mean = (cs - cs_prev) / count
    return (mean - u.astype(jnp.float32)).astype(u.dtype)


def multiscale_pool(u, w_pool, b_pool, pool_scale):
    B, S, _ = u.shape
    ug = u.reshape(B, S, N_POOL_GROUPS, POOL_GROUP)
    pooled = jnp.stack([causal_pool_minus_identity(ug[:, :, g], POOL_WINDOWS[g])
                        for g in range(N_POOL_GROUPS)], axis=2)
    y = jnp.einsum('bsgc,gcd->bsgd', pooled, w_pool) + b_pool
    return y.reshape(B, S, POOL_WIDTH) * pool_scale


def setup_inputs(seed: int = 0) -> dict:
    key = jax.random.key(seed)
    ks = jax.random.split(key, 8)
    f32 = jnp.float32
    x = jax.random.normal(ks[0], (BATCH, SEQ, D_MODEL), f32)
    norm_gain = 1.0 + 0.02 * jax.random.normal(ks[1], (DEPTH, D_MODEL), f32)
    w_in = jax.random.normal(ks[2], (DEPTH, D_MODEL, IN_WIDTH), f32) * D_MODEL ** -0.5
    w_pool = jax.random.normal(ks[3], (DEPTH, N_POOL_GROUPS, POOL_GROUP, POOL_GROUP), f32) * POOL_GROUP ** -0.5
    b_pool = 0.02 * jax.random.normal(ks[4], (DEPTH, N_POOL_GROUPS, POOL_GROUP), f32)
    pool_scale = 1.0 + 0.02 * jax.random.normal(ks[5], (DEPTH, POOL_WIDTH), f32)
    w_out = jax.random.normal(ks[6], (DEPTH, D_MODEL, D_MODEL), f32) * D_MODEL ** -0.5
    final_gain = 1.0 + 0.02 * jax.random.normal(ks[7], (D_MODEL,), f32)
    return {"x": x, "norm_gain": norm_gain, "w_in": w_in, "w_pool": w_pool,
            "b_pool": b_pool, "pool_scale": pool_scale, "w_out": w_out,
            "final_gain": final_gain}


def reference(x, norm_gain, w_in, w_pool, b_pool, pool_scale, w_out, final_gain):
    B, S, _ = x.shape
    pos = jnp.arange(S, dtype=jnp.float32)
    splits = [ATTN_WIDTH, 2 * ATTN_WIDTH, 3 * ATTN_WIDTH, 4 * ATTN_WIDTH,
              4 * ATTN_WIDTH + POOL_WIDTH]
    for l in range(DEPTH):
        h = rmsnorm(x, norm_gain[l])
        proj = h @ w_in[l]
        q, k, v, g_attn, u, g_pool = jnp.split(proj, splits, axis=-1)

        def heads(t):
            return jnp.transpose(t.reshape(B, S, N_HEADS, HEAD_DIM), (0, 2, 1, 3))

        qh, kh, vh = rope(heads(q), pos), rope(heads(k), pos), heads(v)
        attn = moba_attention(qh, kh, vh)
        attn = jnp.transpose(attn, (0, 2, 1, 3)).reshape(B, S, ATTN_WIDTH)
        attn = attn * jax.nn.silu(g_attn)

        pool = multiscale_pool(u, w_pool[l], b_pool[l], pool_scale[l])
        pool = pool * jax.nn.silu(g_pool)

        mixed = jnp.concatenate([attn, pool], axis=-1)
        x = x + mixed @ w_out[l]
    return rmsnorm(x, final_gain)
```

```cpp
#include <hip/hip_runtime.h>
#include <hip/hip_cooperative_groups.h>
#include <cstdio>
#include <cstdint>
namespace cg = cooperative_groups;

#define LAS __attribute__((address_space(3)))
typedef _Float16 h16;
typedef _Float16 f16x8 __attribute__((ext_vector_type(8)));
typedef _Float16 f16x4 __attribute__((ext_vector_type(4)));
typedef float f32x2 __attribute__((ext_vector_type(2)));
typedef float f32x4 __attribute__((ext_vector_type(4)));
typedef float f32x16 __attribute__((ext_vector_type(16)));
typedef unsigned u32x4 __attribute__((ext_vector_type(4)));
typedef unsigned u32x2 __attribute__((ext_vector_type(2)));

constexpr int DM = 1024, BATCH = 2, SEQ = 8192, MROWS = BATCH * SEQ, NIN = 3072, NH = 8, HD = 64, NBLK = 32, BLK = 256, AW = 512;
constexpr float EPS = 1e-6f;
constexpr float QSCALE = 0.125f * 1.4426950408889634f;

constexpr size_t MiB = 1u << 20;
constexpr size_t WS_CNT = 0;
constexpr size_t WS_KMEAN = 1 * MiB;
constexpr size_t WS_ROPE = 2 * MiB;
constexpr size_t WS_WTIN = 4 * MiB;
constexpr size_t WS_WTOUT = 10 * MiB;
constexpr size_t WS_ROWSS = 12 * MiB;
constexpr size_t WS_LSE = 13 * MiB;
constexpr size_t WS_H = 16 * MiB;
constexpr size_t WS_Q = 48 * MiB;
constexpr size_t WS_K = 64 * MiB;
constexpr size_t WS_VT = 80 * MiB;
constexpr size_t WS_SG = 96 * MiB;
constexpr size_t WS_Z = 112 * MiB;
constexpr size_t WS_SGP = 128 * MiB;
constexpr size_t WS_MIX = 144 * MiB;
constexpr size_t WS_LIST = 176 * MiB;
constexpr size_t WS_OPART = 192 * MiB;
static_assert(WS_SGP - WS_Z == WS_Z - WS_SG, "section stride");

constexpr int LDS_BYTES = 147456;

__device__ const float c_inv_freq[32] = {
    1.0f, 0.7498942017555237f, 0.5623413324356079f, 0.4216965138912201f, 0.3162277638912201f, 0.23713737726211548f, 0.17782793939113617f, 0.1333521455526352f,
    0.10000000149011612f, 0.0749894231557846f, 0.05623413249850273f, 0.04216964915394783f, 0.03162277489900589f, 0.023713737726211548f, 0.017782794311642647f, 0.013335213996469975f,
    0.009999999776482582f, 0.007498942315578461f, 0.005623413249850273f, 0.0042169648222625256f, 0.003162277629598975f, 0.0023713738191872835f, 0.0017782794311642647f, 0.0013335214462131262f,
    0.0010000000474974513f, 0.0007498941849917173f, 0.000562341301701963f, 0.0004216965171508491f, 0.0003162277571391314f, 0.00023713737027719617f, 0.00017782794020604342f, 0.0001333521504420787f};

namespace pg8 {
constexpr int BM = 256, BK = 64, HALF = 128, HTB = HALF * BK * 2, STAGE_BYTES = 8 * HTB, NXCD = 8, WGM = 8;
__host__ __device__ __forceinline__ int lds_byte(int r, int c) { const int st = (r >> 4) * 2 + (c >> 5), rr = r & 15, cc = c & 31, ob = rr * 64 + cc * 2; return st * 1024 + (ob ^ (((ob >> 9) & 1) << 5)); }
__host__ __device__ __forceinline__ void stage_rc(int b, int& R, int& C) { const int st = b / 1024, sb = b % 1024, swz = sb ^ (((sb >> 9) & 1) << 5); R = (st >> 1) * 16 + swz / 64; C = (st & 1) * 32 + (swz % 64) / 2; }
__host__ __device__ __forceinline__ int perm32(int rho) { const int n = rho >> 4, i = rho & 15; return 8 * (i >> 2) + 4 * n + (i & 3); }

struct Unit { int pm, pn; };
struct Gemm { const h16* A; const h16* Bt; int M, N, K; };

struct StaticOrder {
    int nM, nN, nwg, G, c;
    __host__ __device__ void init(int M, int N, int G_, int c_) { nM = M / BM; nN = N / BM; nwg = nM * nN; G = G_; c = c_; }
    __host__ __device__ bool next(int i, Unit& u) const {
        const long L = (long)i * G + c; if (L >= nwg) return false;
        int wgid = (int)L; { const int q = nwg / NXCD, r = nwg % NXCD, xcd = wgid % NXCD, off = wgid / NXCD; wgid = (xcd < r ? xcd * (q + 1) : r * (q + 1) + (xcd - r) * q) + off; }
        const int nig = WGM * nN, gid = wgid / nig, fm = gid * WGM, gsz = (nM - fm) < WGM ? (nM - fm) : WGM;
        u.pm = fm + ((wgid % nig) % gsz); u.pn = (wgid % nig) / gsz; return true;
    }
};

template <class Epi, bool ALIGN_EPI = false>
__device__ __forceinline__ void gemm_phase(LAS unsigned char* lds, const Gemm g, const StaticOrder& S, const Epi& E) {
    const int tid = threadIdx.x, wid = __builtin_amdgcn_readfirstlane(tid >> 6), lane = tid & 63, wr = wid >> 2, wc = wid & 3, fr = lane & 15, fq = lane >> 4;
    const int K = g.K, nt = K / BK;
    unsigned voffA[2], voffB[2];
#pragma unroll
    for (int i = 0; i < 2; ++i) { int R, C; stage_rc(tid * 16 + i * 8192, R, C); const int Rb = Epi::PERM ? ((R & ~31) + perm32(R & 31)) : R;
        voffA[i] = (unsigned)(R * K + C) * 2u; voffB[i] = (unsigned)(Rb * K + C) * 2u; }
    const size_t kstep = (size_t)(BK * 2);
    const size_t hstep = (size_t)HALF * K * 2;
    const size_t tstep = 2 * hstep;
    const unsigned ldsw = (unsigned)wid * 1024u;
    const int aoff = lds_byte(wr * 64 + fr, fq * 8), boff = lds_byte(wc * 32 + fr, fq * 8);
#define PG8_SA(b, h) (((b) * 2 + (h)) * HTB)
#define PG8_SB(b, h) ((4 + (b) * 2 + (h)) * HTB)
#define PG8_STAGE(bufoff, gbase, voff) do { _Pragma("unroll") for (int _i = 0; _i < 2; ++_i) \
        __builtin_amdgcn_global_load_lds((const unsigned*)((const char*)(gbase) + (voff)[_i]), (LAS unsigned*)(lds + (bufoff) + ldsw + _i * 8192), 16, 0, 0); } while (0)
#define PG8_LDA(dst, b, h) do { _Pragma("unroll") for (int m = 0; m < 4; ++m) _Pragma("unroll") for (int k = 0; k < 2; ++k) dst[m][k] = *(const LAS f16x8*)(lds + PG8_SA(b, h) + aoff + m * 2048 + k * 1024); } while (0)
#define PG8_LDB(dst, b, h) do { _Pragma("unroll") for (int n = 0; n < 2; ++n) _Pragma("unroll") for (int k = 0; k < 2; ++k) dst[n][k] = *(const LAS f16x8*)(lds + PG8_SB(b, h) + boff + n * 2048 + k * 1024); } while (0)
#define PG8_MMA(ai, bj, At, Bt) do { __builtin_amdgcn_s_setprio(1); _Pragma("unroll") for (int m = 0; m < 4; ++m) _Pragma("unroll") for (int n = 0; n < 2; ++n) _Pragma("unroll") for (int k = 0; k < 2; ++k) \
        acc[ai][bj][m][n] = __builtin_amdgcn_mfma_f32_16x16x32_f16(Bt[n][k], At[m][k], acc[ai][bj][m][n], 0, 0, 0); __builtin_amdgcn_s_setprio(0); } while (0)
#define PG8_WAIT_V(n) asm volatile("s_waitcnt vmcnt(" #n ")" ::: "memory")
#define PG8_WAIT_L(n) asm volatile("s_waitcnt lgkmcnt(" #n ")" ::: "memory")
#define PG8_BAR __builtin_amdgcn_s_barrier()
#define PG8_SCHED __builtin_amdgcn_sched_barrier(0)
    Unit cur, nxt; int ui = 0;
    if (!S.next(0, cur)) return;
    f32x4 acc[2][2][4][2];
#pragma unroll
    for (int a = 0; a < 2; ++a)
#pragma unroll
        for (int b = 0; b < 2; ++b)
#pragma unroll
            for (int m = 0; m < 4; ++m)
#pragma unroll
                for (int n = 0; n < 2; ++n) acc[a][b][m][n] = (f32x4){0.f, 0.f, 0.f, 0.f};
    f16x8 At[4][2], B0[2][2], B1[2][2];
    const char* cA = (const char*)g.A + (size_t)cur.pm * tstep; const char* cB = (const char*)g.Bt + (size_t)cur.pn * tstep;
    PG8_STAGE(PG8_SB(0, 0), cB, voffB); PG8_STAGE(PG8_SB(0, 1), cB + hstep, voffB); PG8_STAGE(PG8_SA(0, 0), cA, voffA); PG8_STAGE(PG8_SA(0, 1), cA + hstep, voffA);
    if (wr == 1) PG8_BAR;
    PG8_WAIT_V(2); PG8_BAR;
    PG8_STAGE(PG8_SB(1, 0), cB + kstep, voffB); PG8_STAGE(PG8_SA(1, 0), cA + kstep, voffA); PG8_STAGE(PG8_SB(1, 1), cB + hstep + kstep, voffB);
    PG8_WAIT_V(6); PG8_BAR;
    for (;;) {
        const bool has_next = S.next(ui + 1, nxt);
        const char* nA = has_next ? (const char*)g.A + (size_t)nxt.pm * tstep : cA; const char* nB = has_next ? (const char*)g.Bt + (size_t)nxt.pn * tstep : cB;
        for (int t = 0; t < nt; t += 2) {
            const bool last = (t == nt - 2);
            const char* a1 = cA + (size_t)(t + 1) * kstep;
            const char* a2 = last ? nA : cA + (size_t)(t + 2) * kstep; const char* b2 = last ? nB : cB + (size_t)(t + 2) * kstep;
            const char* a3 = a2 + kstep; const char* b3 = b2 + kstep;
            PG8_LDB(B0, 0, 0); PG8_LDB(B1, 0, 1); PG8_SCHED; PG8_LDA(At, 0, 0); PG8_STAGE(PG8_SA(1, 1), a1 + hstep, voffA);
            PG8_WAIT_V(8); PG8_WAIT_L(0); PG8_BAR; PG8_MMA(0, 0, At, B0); PG8_MMA(0, 1, At, B1); PG8_BAR; PG8_SCHED;
            PG8_LDA(At, 0, 1); PG8_STAGE(PG8_SB(0, 0), b2, voffB); PG8_STAGE(PG8_SB(0, 1), b2 + hstep, voffB); PG8_STAGE(PG8_SA(0, 0), a2, voffA);
            PG8_WAIT_V(8); PG8_WAIT_L(0); PG8_BAR; PG8_MMA(1, 0, At, B0); PG8_MMA(1, 1, At, B1); PG8_BAR; PG8_SCHED;
            PG8_LDB(B0, 1, 0); PG8_LDB(B1, 1, 1); PG8_SCHED; PG8_LDA(At, 1, 0); PG8_STAGE(PG8_SA(0, 1), a2 + hstep, voffA);
            PG8_WAIT_V(8); PG8_WAIT_L(0); PG8_BAR; PG8_MMA(0, 0, At, B0); PG8_MMA(0, 1, At, B1); PG8_BAR; PG8_SCHED;
            PG8_LDA(At, 1, 1); PG8_STAGE(PG8_SB(1, 0), b3, voffB); PG8_STAGE(PG8_SB(1, 1), b3 + hstep, voffB); PG8_STAGE(PG8_SA(1, 0), a3, voffA);
            PG8_WAIT_V(8); PG8_WAIT_L(0); PG8_BAR; PG8_MMA(1, 0, At, B0); PG8_MMA(1, 1, At, B1); PG8_BAR; PG8_SCHED;
        }
        if constexpr (ALIGN_EPI) { if (wr == 0) PG8_BAR; }
        E(acc, cur, wr, wc, fr, fq);
        if (!has_next) break;
#pragma unroll
        for (int a = 0; a < 2; ++a)
#pragma unroll
            for (int b = 0; b < 2; ++b)
#pragma unroll
                for (int m = 0; m < 4; ++m)
#pragma unroll
                    for (int n = 0; n < 2; ++n) acc[a][b][m][n] = (f32x4){0.f, 0.f, 0.f, 0.f};
        cur = nxt; cA = nA; cB = nB; ++ui;
        if constexpr (ALIGN_EPI) { if (wr == 1) PG8_BAR; }
    }
    PG8_WAIT_V(0);
    if constexpr (!ALIGN_EPI) { if (wr == 0) PG8_BAR; }
    PG8_BAR;
#undef PG8_SA
#undef PG8_SB
#undef PG8_STAGE
#undef PG8_LDA
#undef PG8_LDB
#undef PG8_MMA
#undef PG8_WAIT_V
#undef PG8_WAIT_L
#undef PG8_BAR
#undef PG8_SCHED
}
}

__device__ __forceinline__ f16x4 cvt4(f32x4 v) { return __builtin_convertvector(v, f16x4); }
__device__ __forceinline__ float silu_f(float x) { return x * __builtin_amdgcn_rcpf(1.0f + __expf(-x)); }
__device__ __forceinline__ float wave_sum(float v) {
#pragma unroll
    for (int o = 1; o < 64; o <<= 1) v += __shfl_xor(v, o);
    return v;
}

struct Params {
    const float *x, *norm_gain, *w_in, *w_pool, *b_pool, *pool_scale, *w_out, *final_gain;
    float* out; unsigned char* ws; int ph_lo, ph_hi;
};

struct EpiProj {
    static constexpr bool PERM = true;
    unsigned char* ws; const float* rope; float* kmean;
    __device__ __forceinline__ void operator()(const f32x4 (&acc)[2][2][4][2], const pg8::Unit& u, int wr, int wc, int fr, int fq) const {
        const int sec = u.pn >> 1;
        const int row0 = u.pm * 256 + wr * 64 + fr;
        const int colsec = (u.pn & 1) * 256 + wc * 32 + 8 * fq;
        const int b = u.pm >> 5;
#ifndef EP_MASK
#define EP_MASK 7
#endif
        if ((EP_MASK & 1) && sec <= 1) {
            h16* dstb = (h16*)(ws + WS_Q + (size_t)sec * (WS_K - WS_Q)); const float sc = sec == 0 ? QSCALE : 1.0f;
#pragma unroll
            for (int bj = 0; bj < 2; ++bj) {
                const int col = colsec + bj * 128, head = col >> 6, g4 = ((col & 63) >> 3) * 4;
                f32x4 cs1 = {0.f, 0.f, 0.f, 0.f}, cs2 = {0.f, 0.f, 0.f, 0.f};
#pragma unroll
                for (int ai = 0; ai < 2; ++ai)
#pragma unroll
                    for (int m = 0; m < 4; ++m) {
                        const int row = row0 + ai * 128 + m * 16, s = row & (SEQ - 1);
                        const unsigned ro = (unsigned)(s * 64 + g4);
                        const f32x4 co = *(const f32x4*)(rope + ro), si = *(const f32x4*)(rope + ro + 32u);
                        const f32x4 x1 = acc[ai][bj][m][0], x2 = acc[ai][bj][m][1];
                        const f32x4 o1 = x1 * co - x2 * si, o2 = x2 * co + x1 * si;
                        cs1 += o1; cs2 += o2;
                        const unsigned dof = (unsigned)(((b * NH + head) * SEQ + s) * HD + g4);
                        *(f16x4*)(dstb + dof) = cvt4(o1 * sc); *(f16x4*)(dstb + dof + 32u) = cvt4(o2 * sc);
                        if (m & 1) asm volatile("" ::: "memory");
                    }
                if (sec == 1) {
#pragma unroll
                    for (int i = 0; i < 4; ++i) {
#pragma unroll
                        for (int o = 1; o < 16; o <<= 1) { cs1[i] += __shfl_xor(cs1[i], o); cs2[i] += __shfl_xor(cs2[i], o); }
                    }
                    if (fr == 0) {
                        float* km = kmean + ((size_t)(b * NH + head) * NBLK + (u.pm & 31)) * HD;
#pragma unroll
                        for (int i = 0; i < 4; ++i) { atomicAdd(km + g4 + i, cs1[i] * (1.0f / 256.0f)); atomicAdd(km + 32 + g4 + i, cs2[i] * (1.0f / 256.0f)); }
                    }
                }
            }
        } else if ((EP_MASK & 2) && sec == 2) {
#pragma unroll
            for (int bj = 0; bj < 2; ++bj) {
                const int col = colsec + bj * 128, head = col >> 6, d0 = col & 63;
                h16* vb = (h16*)(ws + WS_VT); const unsigned vo0 = (unsigned)(((b * NH + head) * HD + d0) * SEQ);
#pragma unroll
                for (int ai = 0; ai < 2; ++ai)
#pragma unroll
                    for (int m = 0; m < 4; ++m) {
                        const int row = row0 + ai * 128 + m * 16, s = row & (SEQ - 1);
#pragma unroll
                        for (int n = 0; n < 2; ++n)
#pragma unroll
                            for (int i = 0; i < 4; ++i) vb[vo0 + (unsigned)((4 * n + i) * SEQ + s)] = (h16)acc[ai][bj][m][n][i];
                        if (m & 1) asm volatile("" ::: "memory");
                    }
            }
        } else if (EP_MASK & 4) {
            h16* dstb = (h16*)(ws + WS_SG + (size_t)(sec - 3) * (WS_Z - WS_SG));
#pragma unroll
            for (int bj = 0; bj < 2; ++bj) {
                const int col = colsec + bj * 128;
#pragma unroll
                for (int ai = 0; ai < 2; ++ai)
#pragma unroll
                    for (int m = 0; m < 4; ++m) {
                        const int row = row0 + ai * 128 + m * 16;
                        const f32x4 a0 = acc[ai][bj][m][0], a1 = acc[ai][bj][m][1];
                        const f32x4 s0 = {silu_f(a0[0]), silu_f(a0[1]), silu_f(a0[2]), silu_f(a0[3])}, s1 = {silu_f(a1[0]), silu_f(a1[1]), silu_f(a1[2]), silu_f(a1[3])};
                        const f16x4 a = cvt4(sec != 4 ? s0 : a0), c = cvt4(sec != 4 ? s1 : a1);
                        f16x8 o = {a[0], a[1], a[2], a[3], c[0], c[1], c[2], c[3]};
                        *(f16x8*)(dstb + (unsigned)(row * AW + col)) = o;
                    }
            }
        }
    }
};

struct EpiRes {
    static constexpr bool PERM = false;
    const float* x; float* out; float* rowss;
    __device__ __forceinline__ void operator()(const f32x4 (&acc)[2][2][4][2], const pg8::Unit& u, int wr, int wc, int fr, int fq) const {
        const int row0 = u.pm * 256 + wr * 64 + fr, col0 = u.pn * 256 + wc * 32 + 4 * fq;
#pragma unroll
        for (int ai = 0; ai < 2; ++ai)
#pragma unroll
            for (int m = 0; m < 4; ++m) {
                const int row = row0 + ai * 128 + m * 16; float ss = 0.f;
#pragma unroll
                for (int bj = 0; bj < 2; ++bj)
#pragma unroll
                    for (int n = 0; n < 2; ++n) {
                        const size_t off = (size_t)row * DM + col0 + bj * 128 + n * 16;
                        const f32x4 y = *(const f32x4*)(x + off) + acc[ai][bj][m][n];
                        *(f32x4*)(out + off) = y; ss += (y[0] * y[0] + y[1] * y[1]) + (y[2] * y[2] + y[3] * y[3]);
                    }
                ss += __shfl_xor(ss, 16); ss += __shfl_xor(ss, 32);
                if (fq == 0) rowss[(size_t)row * 16 + u.pn * 4 + wc] = ss;
            }
    }
};

__device__ __forceinline__ void p0_transpose_item(const float* W, int ldw, h16* WT, int n0, int k0, bool qkperm, LAS float* scr, int lane) {
    const int np = n0 + (lane & 31);
    int nl = np;
    if (qkperm) { const int p = np & 63, g = p >> 3, i = p & 7; nl = (np & ~63) + 4 * g + (i & 3) + 32 * (i >> 2); }
#pragma unroll 8
    for (int i = 0; i < 32; ++i) { const int kk = 2 * i + (lane >> 5); scr[kk * 33 + (lane & 31)] = W[(size_t)(k0 + kk) * ldw + nl]; }
    asm volatile("s_waitcnt lgkmcnt(0)" ::: "memory");
    const int c = lane & 7;
#pragma unroll
    for (int j = 0; j < 4; ++j) { const int n = (lane >> 3) + 8 * j; const LAS float* s = scr + (8 * c) * 33 + n;
        f16x8 o = {(h16)s[0 * 33], (h16)s[1 * 33], (h16)s[2 * 33], (h16)s[3 * 33], (h16)s[4 * 33], (h16)s[5 * 33], (h16)s[6 * 33], (h16)s[7 * 33]};
        *(f16x8*)(WT + (size_t)(n0 + n) * DM + k0 + 8 * c) = o; }
    asm volatile("s_waitcnt lgkmcnt(0)" ::: "memory");
}

__device__ __forceinline__ void sincos_d(double x, float& c, float& s) {
    const double n = __builtin_rint(x * 0.63661977236758134308);
    double r = __builtin_fma(-n, 1.5707963267948966, x); r = __builtin_fma(-n, 6.123233995736766e-17, r);
    const double r2 = r * r;
    double sp = -1.0 / 39916800.0; sp = sp * r2 + 1.0 / 362880.0; sp = sp * r2 - 1.0 / 5040.0; sp = sp * r2 + 1.0 / 120.0; sp = sp * r2 - 1.0 / 6.0; const double sn = r + r * r2 * sp;
    double cp = 1.0 / 479001600.0; cp = cp * r2 - 1.0 / 3628800.0; cp = cp * r2 + 1.0 / 40320.0; cp = cp * r2 - 1.0 / 720.0; cp = cp * r2 + 1.0 / 24.0; cp = cp * r2 - 0.5; const double cn = 1.0 + r2 * cp;
    const int q = ((int)n) & 3;
    const double ss = (q & 1) ? cn : sn, cc = (q & 1) ? sn : cn;
    s = (float)((q & 2) ? -ss : ss); c = (float)(((q + 1) & 2) ? -cc : cc);
}

__device__ __forceinline__ void p0_prologue(const Params& P, LAS unsigned char* lds) {
    const int tid = threadIdx.x, lane = tid & 63, wave = tid >> 6, bid = blockIdx.x, G = gridDim.x;
    unsigned char* ws = P.ws;
    { int* cnt = (int*)(ws + WS_CNT); float* km = (float*)(ws + WS_KMEAN);
      for (int i = bid * 512 + tid; i < 512 + 16 * NBLK * HD; i += G * 512) { if (i < 512) cnt[i] = 0; else km[i - 512] = 0.f; } }
    const int NFB = G >= 128 ? 64 : G;
    if (bid < NFB) {
        LAS float* A = (LAS float*)lds; LAS float* Wp = (LAS float*)(lds + 34816);
        for (int fi = bid; fi < 64; fi += NFB) {
            const int k0 = (fi >> 2) * 64, g = fi & 3;
            for (int i = 0; i < 16; ++i) { const int idx = tid + 512 * i, kk = idx >> 7, j = idx & 127; A[kk * 132 + j] = P.w_in[(size_t)(k0 + kk) * NIN + 2048 + 128 * g + j]; }
            for (int i = 0; i < 32; ++i) { const int idx = tid + 512 * i; Wp[idx] = P.w_pool[(size_t)g * 16384 + idx]; }
            __syncthreads();
            const int cc = tid & 127, kq = tid >> 7;
            float a[16];
#pragma unroll
            for (int r = 0; r < 16; ++r) a[r] = 0.f;
            for (int j4 = 0; j4 < 32; ++j4) {
                const float w0 = Wp[(4 * j4 + 0) * 128 + cc], w1 = Wp[(4 * j4 + 1) * 128 + cc], w2 = Wp[(4 * j4 + 2) * 128 + cc], w3 = Wp[(4 * j4 + 3) * 128 + cc];
#pragma unroll
                for (int r = 0; r < 16; ++r) { const f32x4 av = *(const LAS f32x4*)(A + (kq * 16 + r) * 132 + 4 * j4); a[r] += av[0] * w0 + av[1] * w1 + av[2] * w2 + av[3] * w3; }
            }
            h16* dst = (h16*)(ws + WS_WTIN) + (size_t)(2048 + 128 * g + cc) * DM + k0 + kq * 16;
            f16x8 o0 = {(h16)a[0], (h16)a[1], (h16)a[2], (h16)a[3], (h16)a[4], (h16)a[5], (h16)a[6], (h16)a[7]};
            f16x8 o1 = {(h16)a[8], (h16)a[9], (h16)a[10], (h16)a[11], (h16)a[12], (h16)a[13], (h16)a[14], (h16)a[15]};
            *(f16x8*)dst = o0; *(f16x8*)(dst + 8) = o1;
            __syncthreads();
        }
        LAS float* scr = (LAS float*)(lds + wave * 16384);
        const int gw = bid * 8 + wave, NGW = NFB * 8;
        for (int it = gw; it < 16 * 80 + 16 * 32; it += NGW) {
            if (it < 16 * 80) { const int kb = it / 80, nb = it % 80, nbp = nb < 64 ? nb : nb + 16;
                p0_transpose_item(P.w_in, NIN, (h16*)(ws + WS_WTIN), nbp * 32, kb * 64, nbp < 32, scr, lane); }
            else { const int r = it - 16 * 80, kb = r / 32, nb = r % 32;
                p0_transpose_item(P.w_out, DM, (h16*)(ws + WS_WTOUT), nb * 32, kb * 64, false, scr, lane); }
        }
        float* rope = (float*)(ws + WS_ROPE);
        for (int i = bid * 512 + tid; i < SEQ * 32; i += NFB * 512) {
            const int s = i >> 5, j = i & 31; const float ang = (float)s * c_inv_freq[j];
            float c, sn; sincos_d((double)ang, c, sn); rope[(size_t)s * 64 + j] = c; rope[(size_t)s * 64 + 32 + j] = sn;
        }
    }
    {
        const int nb = G >= 128 ? G - NFB : G, b0 = G >= 128 ? bid - NFB : bid;
        if (b0 >= 0) {
            f32x4 gn[4];
#pragma unroll
            for (int j = 0; j < 4; ++j) gn[j] = *((const f32x4*)P.norm_gain + lane + 64 * j);
            h16* H = (h16*)(ws + WS_H);
            for (int m = b0 * 8 + wave; m < MROWS; m += nb * 8) {
                const f32x4* xr = (const f32x4*)(P.x + (size_t)m * DM) + lane;
                f32x4 v[4]; float ss = 0.f;
#pragma unroll
                for (int j = 0; j < 4; ++j) { v[j] = xr[64 * j]; ss += (v[j][0] * v[j][0] + v[j][1] * v[j][1]) + (v[j][2] * v[j][2] + v[j][3] * v[j][3]); }
                const float rstd = 1.0f / sqrtf(wave_sum(ss) * (1.0f / DM) + EPS);
#pragma unroll
                for (int j = 0; j < 4; ++j) *(f16x4*)(H + (size_t)m * DM + 4 * lane + 256 * j) = cvt4(v[j] * rstd * gn[j]);
            }
        }
    }
}

__device__ __forceinline__ void p2_gate(const Params& P) {
    const int tid = threadIdx.x, lane = tid & 63, wave = tid >> 6, G = gridDim.x;
    unsigned char* ws = P.ws;
    const h16* Q = (const h16*)(ws + WS_Q); const float* kmean = (const float*)(ws + WS_KMEAN);
    int* cnt = (int*)(ws + WS_CNT); int* list = (int*)(ws + WS_LIST);
    for (int it = blockIdx.x * 8 + wave; it < 16 * 128; it += G * 8) {
        const int bh = __builtin_amdgcn_readfirstlane(it >> 7), s0 = (it & 127) * 64, blk = __builtin_amdgcn_readfirstlane(s0 >> 8);
        if (blk == 0) continue;
        const int s = s0 + lane;
        float qf[64];
        { const f16x8* qp = (const f16x8*)(Q + ((size_t)bh * SEQ + s) * HD);
#pragma unroll
          for (int c = 0; c < 8; ++c) { const f16x8 v = qp[c];
#pragma unroll
              for (int i = 0; i < 8; ++i) qf[8 * c + i] = (float)v[i]; } }
        float v0 = -INFINITY, v1 = -INFINITY, v2 = -INFINITY; int i0 = 0, i1 = 1, i2 = 2;
        for (int n = 0; n < blk; ++n) {
            const float* km = kmean + ((size_t)bh * NBLK + n) * HD;
            float ga = 0.f, gb = 0.f;
#pragma unroll
            for (int d = 0; d < 64; d += 2) { ga += qf[d] * km[d]; gb += qf[d + 1] * km[d + 1]; }
            const float gt = ga + gb;
            if (gt > v0) { v2 = v1; i2 = i1; v1 = v0; i1 = i0; v0 = gt; i0 = n; }
            else if (gt > v1) { v2 = v1; i2 = i1; v1 = gt; i1 = n; }
            else if (gt > v2) { v2 = gt; i2 = n; }
        }
        const int nsel = blk < 3 ? blk : 3;
        for (int n = 0; n < blk; ++n) {
            int k = -1;
            if (i0 == n) k = 0; else if (nsel > 1 && i1 == n) k = 1; else if (nsel > 2 && i2 == n) k = 2;
            const unsigned long long mask = __ballot(k >= 0);
            if (mask == 0ull) continue;
            const int first = __ffsll((long long)mask) - 1;
            int base = 0;
            if (lane == first) base = atomicAdd(cnt + bh * NBLK + n, __popcll(mask));
            base = __shfl(base, first);
            if (k >= 0) { const int rank = __popcll(mask & ((1ull << lane) - 1ull)); list[((size_t)bh * NBLK + n) * SEQ + base + rank] = s | (k << 13); }
        }
    }
}

constexpr int KLD = 144, VLD = 520;
constexpr int LDS_KOFF = 0, LDS_VOFF = 256 * KLD;
__device__ __forceinline__ int crow(int r, int hi) { return (r & 3) + 8 * (r >> 2) + 4 * hi; }

template <bool OWN>
__device__ __forceinline__ void attn_unit(const Params& P, LAS unsigned char* lds, int bh, int n, const int* lst, int count) {
    const int tid = threadIdx.x, lane = tid & 63, wave = __builtin_amdgcn_readfirstlane(tid >> 6), r32 = lane & 31, hi = lane >> 5;
    unsigned char* ws = P.ws;
    const h16* Q = (const h16*)(ws + WS_Q); const h16* K = (const h16*)(ws + WS_K); const h16* Vt = (const h16*)(ws + WS_VT);
    {
        const u32x4* kg = (const u32x4*)(K + ((size_t)bh * SEQ + (size_t)n * BLK) * HD);
#pragma unroll
        for (int i = 0; i < 4; ++i) { const int ch = tid + 512 * i; const u32x4 v = kg[ch]; *(LAS u32x4*)(lds + LDS_KOFF + (ch >> 3) * KLD + (ch & 7) * 16) = v; }
#pragma unroll
        for (int i = 0; i < 4; ++i) { const int ch = tid + 512 * i, d = ch >> 5, c16 = ch & 31;
            const u32x4 v = *(const u32x4*)(Vt + ((size_t)bh * HD + d) * SEQ + (size_t)n * BLK + c16 * 8);
            LAS u32x2* dst = (LAS u32x2*)(lds + LDS_VOFF + d * VLD + c16 * 16); dst[0] = (u32x2){v[0], v[1]}; dst[1] = (u32x2){v[2], v[3]}; }
    }
    int s, kslot = 3; bool valid;
    if (OWN) { s = n * BLK + wave * 32 + r32; valid = true; }
    else { int idx = wave * 32 + r32; valid = idx < count; if (!valid) idx = count - 1; const int e = lst[idx]; s = e & 8191; kslot = e >> 13; }
    const bool wave_active = OWN ? true : (wave * 32 < count);
    f16x8 qf[4];
    { const f16x8* qp = (const f16x8*)(Q + ((size_t)bh * SEQ + s) * HD);
#pragma unroll
      for (int d0 = 0; d0 < 4; ++d0) qf[d0] = qp[2 * d0 + hi]; }
    __syncthreads();
    if (wave_active) {
        f32x16 S[8];
#pragma unroll
        for (int kt = 0; kt < 8; ++kt) {
            if (!OWN || kt <= wave) {
                f32x16 a = {};
#pragma unroll
                for (int d0 = 0; d0 < 4; ++d0) {
                    const f16x8 kf = *(const LAS f16x8*)(lds + LDS_KOFF + (32 * kt + r32) * KLD + 32 * d0 + 16 * hi);
                    a = __builtin_amdgcn_mfma_f32_32x32x16_f16(kf, qf[d0], a, 0, 0, 0);
                }
                if (OWN && kt == wave) {
#pragma unroll
                    for (int r = 0; r < 16; ++r) if (crow(r, hi) > r32) a[r] = -INFINITY;
                }
                S[kt] = a;
            }
        }
        float mx = -INFINITY;
#pragma unroll
        for (int kt = 0; kt < 8; ++kt) if (!OWN || kt <= wave) {
#pragma unroll
            for (int r = 0; r < 16; ++r) mx = fmaxf(mx, S[kt][r]);
        }
        mx = fmaxf(mx, __shfl_xor(mx, 32));
        float l = 0.f;
        f32x16 O[2]; O[0] = (f32x16){}; O[1] = (f32x16){};
#pragma unroll
        for (int kt = 0; kt < 8; ++kt) if (!OWN || kt <= wave) {
            f32x16 p = S[kt];
#pragma unroll
            for (int r = 0; r < 16; ++r) { p[r] = __builtin_amdgcn_exp2f(p[r] - mx); l += p[r]; }
#pragma unroll
            for (int st = 0; st < 2; ++st) {
                const f16x4 pa = cvt4((f32x4){p[8 * st], p[8 * st + 1], p[8 * st + 2], p[8 * st + 3]}), pb = cvt4((f32x4){p[8 * st + 4], p[8 * st + 5], p[8 * st + 6], p[8 * st + 7]});
                const f16x8 pf = {pa[0], pa[1], pa[2], pa[3], pb[0], pb[1], pb[2], pb[3]};
#pragma unroll
                for (int d1 = 0; d1 < 2; ++d1) {
                    const LAS unsigned char* vp = lds + LDS_VOFF + (32 * d1 + r32) * VLD + (32 * kt + 16 * st + 4 * hi) * 2;
                    const f16x4 va = *(const LAS f16x4*)vp, vb = *(const LAS f16x4*)(vp + 16);
                    const f16x8 vf = {va[0], va[1], va[2], va[3], vb[0], vb[1], vb[2], vb[3]};
                    O[d1] = __builtin_amdgcn_mfma_f32_32x32x16_f16(vf, pf, O[d1], 0, 0, 0);
                }
            }
        }
        l += __shfl_xor(l, 32);
        const float rl = 1.0f / l;
        if (!OWN) {
            if (valid) {
                h16* op = (h16*)(ws + WS_OPART) + (((size_t)bh * SEQ + s) * 3 + kslot) * HD;
#pragma unroll
                for (int d1 = 0; d1 < 2; ++d1)
#pragma unroll
                    for (int g = 0; g < 4; ++g)
                        *(f16x4*)(op + 32 * d1 + 8 * g + 4 * hi) = cvt4((f32x4){O[d1][4 * g] * rl, O[d1][4 * g + 1] * rl, O[d1][4 * g + 2] * rl, O[d1][4 * g + 3] * rl});
                if (hi == 0) ((float*)(ws + WS_LSE))[((size_t)bh * SEQ + s) * 4 + kslot] = mx + log2f(l);
            }
        } else {
            const int nsel = n < 3 ? n : 3;
            const float lse_own = mx + log2f(l);
            float lk[3] = {-INFINITY, -INFINITY, -INFINITY};
            const float* lsep = (const float*)(ws + WS_LSE) + ((size_t)bh * SEQ + s) * 4;
#pragma unroll
            for (int k = 0; k < 3; ++k) if (k < nsel) lk[k] = lsep[k];
            const float M = fmaxf(fmaxf(lse_own, lk[0]), fmaxf(lk[1], lk[2]));
            const float w_own = __builtin_amdgcn_exp2f(lse_own - M);
            float wk[3]; float den = w_own;
#pragma unroll
            for (int k = 0; k < 3; ++k) { wk[k] = __builtin_amdgcn_exp2f(lk[k] - M); den += wk[k]; }
            const float rden = 1.0f / den, so = w_own * rl * rden;
            const int b = bh >> 3, head = bh & 7; const size_t row = (size_t)b * SEQ + s;
            const h16* op = (const h16*)(ws + WS_OPART) + ((size_t)bh * SEQ + s) * 3 * HD;
            const h16* sg = (const h16*)(ws + WS_SG) + row * AW + head * HD;
            h16* mix = (h16*)(ws + WS_MIX) + row * DM + head * HD;
#pragma unroll
            for (int d1 = 0; d1 < 2; ++d1)
#pragma unroll
                for (int g = 0; g < 4; ++g) {
                    const int d = 32 * d1 + 8 * g + 4 * hi;
                    f32x4 o = {O[d1][4 * g] * so, O[d1][4 * g + 1] * so, O[d1][4 * g + 2] * so, O[d1][4 * g + 3] * so};
#pragma unroll
                    for (int k = 0; k < 3; ++k) if (k < nsel) { const f16x4 pv = *(const f16x4*)(op + k * HD + d); const float w = wk[k] * rden;
                        o[0] += w * (float)pv[0]; o[1] += w * (float)pv[1]; o[2] += w * (float)pv[2]; o[3] += w * (float)pv[3]; }
                    const f16x4 gv = *(const f16x4*)(sg + d);
                    o[0] *= (float)gv[0]; o[1] *= (float)gv[1]; o[2] *= (float)gv[2]; o[3] *= (float)gv[3];
                    *(f16x4*)(mix + d) = cvt4(o);
                }
        }
    }
    __syncthreads();
}

__device__ __forceinline__ void p3_selected(const Params& P, LAS unsigned char* lds) {
    const int tid = threadIdx.x, G = gridDim.x;
    LAS int* pref = (LAS int*)(lds + 73728);
    LAS int* cntl = (LAS int*)(lds + 73728 + 4096);
    const int* cnt = (const int*)(P.ws + WS_CNT);
    const int c = cnt[tid]; cntl[tid] = c;
    int v = (c + 255) >> 8;
    LAS int* sc = (LAS int*)(lds + 73728 + 8192);
    sc[tid] = v; __syncthreads();
    int pp = 0;
    for (int o = 1; o < 512; o <<= 1) { const int a = sc[pp * 512 + tid] + (tid >= o ? sc[pp * 512 + tid - o] : 0); sc[(pp ^ 1) * 512 + tid] = a; pp ^= 1; __syncthreads(); }
    pref[tid + 1] = sc[pp * 512 + tid]; if (tid == 0) pref[0] = 0;
    __syncthreads();
    const int NU = pref[512];
    for (int u = blockIdx.x; u < NU; u += G) {
        int lo = 0, hi = 512;
        while (hi - lo > 1) { const int mid = (lo + hi) >> 1; if (pref[mid] <= u) lo = mid; else hi = mid; }
        const int ch = u - pref[lo], bh = lo >> 5, n = lo & 31;
        int count = cntl[lo] - ch * 256; count = count > 256 ? 256 : count;
        attn_unit<false>(P, lds, bh, n, (const int*)(P.ws + WS_LIST) + (size_t)lo * SEQ + ch * 256, count);
    }
}

__device__ __forceinline__ void p4_own_pool(const Params& P, LAS unsigned char* lds) {
    const int tid = threadIdx.x, G = gridDim.x;
    for (int u = blockIdx.x; u < 16 * NBLK; u += G) {
        const int bh = u & 15, n = 31 - (u >> 4);
        attn_unit<true>(P, lds, bh, n, nullptr, 256);
    }
    unsigned char* ws = P.ws;
    const h16* Z = (const h16*)(ws + WS_Z); const h16* SGP = (const h16*)(ws + WS_SGP); h16* MIX = (h16*)(ws + WS_MIX);
    for (int it = blockIdx.x * 512 + tid; it < MROWS * 64; it += G * 512) {
        const int row = it >> 6, c0 = (it & 63) * 8, s = row & (SEQ - 1), w = 2 << (c0 >> 7);
        const int cn = (s + 1) < w ? (s + 1) : w;
        float acc[8] = {0.f, 0.f, 0.f, 0.f, 0.f, 0.f, 0.f, 0.f}; float z0[8];
        for (int i = 0; i < cn; ++i) { const f16x8 zv = *(const f16x8*)(Z + (size_t)(row - i) * AW + c0);
#pragma unroll
            for (int j = 0; j < 8; ++j) { const float f = (float)zv[j]; acc[j] += f; if (i == 0) z0[j] = f; } }
        const float rc = 1.0f / (float)cn;
        const f16x8 gv = *(const f16x8*)(SGP + (size_t)row * AW + c0);
        f16x8 o;
#pragma unroll
        for (int j = 0; j < 8; ++j) o[j] = (h16)((acc[j] * rc - z0[j] + P.b_pool[c0 + j]) * P.pool_scale[c0 + j] * (float)gv[j]);
        *(f16x8*)(MIX + (size_t)row * DM + AW + c0) = o;
    }
}

__device__ __forceinline__ void p6_final(const Params& P) {
    const int tid = threadIdx.x, lane = tid & 63, wave = tid >> 6, G = gridDim.x;
    const float* rowss = (const float*)(P.ws + WS_ROWSS);
    f32x4 gn[4];
#pragma unroll
    for (int j = 0; j < 4; ++j) gn[j] = *((const f32x4*)P.final_gain + lane + 64 * j);
    for (int m = blockIdx.x * 8 + wave; m < MROWS; m += G * 8) {
        float ss = rowss[(size_t)m * 16 + (lane & 15)];
#pragma unroll
        for (int o = 1; o < 16; o <<= 1) ss += __shfl_xor(ss, o);
        const float rstd = 1.0f / sqrtf(ss * (1.0f / DM) + EPS);
        f32x4* yr = (f32x4*)(P.out + (size_t)m * DM) + lane;
#pragma unroll
        for (int j = 0; j < 4; ++j) { const f32x4 v = yr[64 * j]; yr[64 * j] = v * rstd * gn[j]; }
    }
}

__global__ void __launch_bounds__(512, 2) hymba_fwd(Params P) {
    extern __shared__ __attribute__((aligned(16))) unsigned char lds_raw[];
    LAS unsigned char* lds = (LAS unsigned char*)lds_raw;
    cg::grid_group grid = cg::this_grid();
    unsigned char* ws = P.ws;
    const int lo = P.ph_lo, hi = P.ph_hi;
#ifndef PHASE_MASK
#define PHASE_MASK 0x7f
#endif
#define IN(k) (((PHASE_MASK >> (k)) & 1) && lo <= (k) && (k) < hi)
#define SEAM(k) do { if (IN(k) && IN((k) + 1)) grid.sync(); } while (0)
    if (IN(0)) p0_prologue(P, lds);
    SEAM(0);
    if (IN(1)) {
        pg8::Gemm g{(const h16*)(ws + WS_H), (const h16*)(ws + WS_WTIN), MROWS, NIN, DM}; pg8::StaticOrder S; S.init(MROWS, NIN, (int)gridDim.x, (int)blockIdx.x);
        EpiProj E{ws, (const float*)(ws + WS_ROPE), (float*)(ws + WS_KMEAN)};
        pg8::gemm_phase<EpiProj, true>(lds, g, S, E);
    }
    SEAM(1);
    if (IN(2)) p2_gate(P);
    SEAM(2);
    if (IN(3)) p3_selected(P, lds);
    SEAM(3);
    if (IN(4)) p4_own_pool(P, lds);
    SEAM(4);
    if (IN(5)) {
        pg8::Gemm g{(const h16*)(ws + WS_MIX), (const h16*)(ws + WS_WTOUT), MROWS, DM, DM}; pg8::StaticOrder S; S.init(MROWS, DM, (int)gridDim.x, (int)blockIdx.x);
        EpiRes E{P.x, P.out, (float*)(ws + WS_ROWSS)};
        pg8::gemm_phase<EpiRes, true>(lds, g, S, E);
    }
    SEAM(5);
    if (IN(6)) p6_final(P);
#undef IN
#undef SEAM
}

#ifndef N_LAUNCHES
#define N_LAUNCHES 1
#endif

extern "C" void kernel_launch(void* const* d_in, const int* in_sizes, int n_in, void* d_out, int out_size, void* d_ws, size_t ws_size, hipStream_t stream) {
    static int grid = 0;
    if (grid == 0) {
        int dev = 0, cus = 0, per_cu = 0;
        (void)hipGetDevice(&dev);
        (void)hipDeviceGetAttribute(&cus, hipDeviceAttributeMultiprocessorCount, dev);
        if (hipFuncSetAttribute((const void*)hymba_fwd, hipFuncAttributeMaxDynamicSharedMemorySize, LDS_BYTES) != hipSuccess) fprintf(stderr, "kernel_launch: hipFuncSetAttribute failed\n");
        if (hipOccupancyMaxActiveBlocksPerMultiprocessor(&per_cu, (const void*)hymba_fwd, 512, LDS_BYTES) != hipSuccess || per_cu < 1) { fprintf(stderr, "kernel_launch: occupancy query says %d\n", per_cu); per_cu = 1; }
        (void)hipGetLastError();
        grid = cus * 1;
        if (grid <= 0) grid = 256;
    }
    Params p{};
    p.x = (const float*)d_in[0]; p.norm_gain = (const float*)d_in[1]; p.w_in = (const float*)d_in[2]; p.w_pool = (const float*)d_in[3];
    p.b_pool = (const float*)d_in[4]; p.pool_scale = (const float*)d_in[5]; p.w_out = (const float*)d_in[6]; p.final_gain = (const float*)d_in[7];
    p.out = (float*)d_out; p.ws = (unsigned char*)d_ws;
    if (N_LAUNCHES == 1) {
        p.ph_lo = 0; p.ph_hi = 7;
        void* args[] = {&p};
        const hipError_t e = hipLaunchCooperativeKernel((const void*)hymba_fwd, dim3(grid), dim3(512), args, LDS_BYTES, stream);
        if (e != hipSuccess) fprintf(stderr, "kernel_launch: cooperative launch failed: %s (grid %d)\n", hipGetErrorString(e), grid);
    } else {
        for (int ph = 0; ph < 7; ++ph) { p.ph_lo = ph; p.ph_hi = ph + 1; hipLaunchKernelGGL(hymba_fwd, dim3(grid), dim3(512), LDS_BYTES, stream, p); }
    }
}
```

```cpp
#include <hip/hip_runtime.h>
#include <hip/hip_cooperative_groups.h>
#include <cstdio>
#include <cstdint>
namespace cg = cooperative_groups;

#define LAS __attribute__((address_space(3)))
typedef _Float16 h16;
typedef _Float16 f16x8 __attribute__((ext_vector_type(8)));
typedef _Float16 f16x4 __attribute__((ext_vector_type(4)));
typedef float f32x2 __attribute__((ext_vector_type(2)));
typedef float f32x4 __attribute__((ext_vector_type(4)));
typedef float f32x16 __attribute__((ext_vector_type(16)));
typedef unsigned u32x4 __attribute__((ext_vector_type(4)));
typedef unsigned u32x2 __attribute__((ext_vector_type(2)));

constexpr int DM = 1024, BATCH = 2, SEQ = 8192, MROWS = BATCH * SEQ, NIN = 3072, NH = 8, HD = 64, NBLK = 32, BLK = 256, AW = 512;
constexpr float EPS = 1e-6f;
constexpr float QSCALE = 0.125f * 1.4426950408889634f;

constexpr size_t MiB = 1u << 20;
constexpr size_t WS_CNT = 0;
constexpr size_t WS_BAR = 512 * 1024;
constexpr size_t WS_KMEAN = 1 * MiB;
constexpr size_t WS_ROPE = 2 * MiB;
constexpr size_t WS_WTIN = 4 * MiB;
constexpr size_t WS_WTOUT = 10 * MiB;
constexpr size_t WS_ROWSS = 12 * MiB;
constexpr size_t WS_LSE = 13 * MiB;
constexpr size_t WS_H = 16 * MiB;
constexpr size_t WS_Q = 48 * MiB;
constexpr size_t WS_K = 64 * MiB;
constexpr size_t WS_VT = 80 * MiB;
constexpr size_t WS_SG = 96 * MiB;
constexpr size_t WS_Z = 112 * MiB;
constexpr size_t WS_SGP = 128 * MiB;
constexpr size_t WS_MIX = 144 * MiB;
constexpr size_t WS_LIST = 176 * MiB;
constexpr size_t WS_OPART = 192 * MiB;
static_assert(WS_SGP - WS_Z == WS_Z - WS_SG, "section stride");

constexpr int LDS_BYTES = 147456;

__device__ const float c_inv_freq[32] = {
    1.0f, 0.7498942017555237f, 0.5623413324356079f, 0.4216965138912201f, 0.3162277638912201f, 0.23713737726211548f, 0.17782793939113617f, 0.1333521455526352f,
    0.10000000149011612f, 0.0749894231557846f, 0.05623413249850273f, 0.04216964915394783f, 0.03162277489900589f, 0.023713737726211548f, 0.017782794311642647f, 0.013335213996469975f,
    0.009999999776482582f, 0.007498942315578461f, 0.005623413249850273f, 0.0042169648222625256f, 0.003162277629598975f, 0.0023713738191872835f, 0.0017782794311642647f, 0.0013335214462131262f,
    0.0010000000474974513f, 0.0007498941849917173f, 0.000562341301701963f, 0.0004216965171508491f, 0.0003162277571391314f, 0.00023713737027719617f, 0.00017782794020604342f, 0.0001333521504420787f};

namespace pg8 {
constexpr int BM = 256, BK = 64, HALF = 128, HTB = HALF * BK * 2, STAGE_BYTES = 8 * HTB, NXCD = 8, WGM = 8;
__host__ __device__ __forceinline__ int lds_byte(int r, int c) { const int st = (r >> 4) * 2 + (c >> 5), rr = r & 15, cc = c & 31, ob = rr * 64 + cc * 2; return st * 1024 + (ob ^ (((ob >> 9) & 1) << 5)); }
__host__ __device__ __forceinline__ void stage_rc(int b, int& R, int& C) { const int st = b / 1024, sb = b % 1024, swz = sb ^ (((sb >> 9) & 1) << 5); R = (st >> 1) * 16 + swz / 64; C = (st & 1) * 32 + (swz % 64) / 2; }
__host__ __device__ __forceinline__ int perm32(int rho) { const int n = rho >> 4, i = rho & 15; return 8 * (i >> 2) + 4 * n + (i & 3); }

struct Unit { int pm, pn; };
struct Gemm { const h16* A; const h16* Bt; int M, N, K; };

struct StaticOrder {
    int nM, nN, nwg, G, c, nrep;
    __host__ __device__ void init(int M, int N, int G_, int c_, int nrep_ = 1) { nM = M / BM; nN = N / BM; nwg = nM * nN; G = G_; c = c_; nrep = nrep_; }
    __host__ __device__ bool next(int i, Unit& u) const {
        const long L = (long)i * G + c; if (L >= (long)nwg * nrep) return false;
        int wgid = (int)(L % nwg); { const int q = nwg / NXCD, r = nwg % NXCD, xcd = wgid % NXCD, off = wgid / NXCD; wgid = (xcd < r ? xcd * (q + 1) : r * (q + 1) + (xcd - r) * q) + off; }
        const int nig = WGM * nN, gid = wgid / nig, fm = gid * WGM, gsz = (nM - fm) < WGM ? (nM - fm) : WGM;
        u.pm = fm + ((wgid % nig) % gsz); u.pn = (wgid % nig) / gsz; return true;
    }
};

template <class Epi, bool ALIGN_EPI = false>
__device__ __forceinline__ void gemm_phase(LAS unsigned char* lds, const Gemm g, const StaticOrder& S, const Epi& E) {
    const int tid = threadIdx.x, wid = __builtin_amdgcn_readfirstlane(tid >> 6), lane = tid & 63, wr = wid >> 2, wc = wid & 3, fr = lane & 15, fq = lane >> 4;
    const int K = g.K, nt = K / BK;
    unsigned voffA[2], voffB[2];
#pragma unroll
    for (int i = 0; i < 2; ++i) { int R, C; stage_rc(tid * 16 + i * 8192, R, C); const int Rb = Epi::PERM ? ((R & ~31) + perm32(R & 31)) : R;
        voffA[i] = (unsigned)(R * K + C) * 2u; voffB[i] = (unsigned)(Rb * K + C) * 2u; }
    const size_t kstep = (size_t)(BK * 2);
    const size_t hstep = (size_t)HALF * K * 2;
    const size_t tstep = 2 * hstep;
    const unsigned ldsw = (unsigned)wid * 1024u;
    const int aoff = lds_byte(wr * 64 + fr, fq * 8), boff = lds_byte(wc * 32 + fr, fq * 8);
#define PG8_SA(b, h) (((b) * 2 + (h)) * HTB)
#define PG8_SB(b, h) ((4 + (b) * 2 + (h)) * HTB)
#define PG8_STAGE(bufoff, gbase, voff) do { _Pragma("unroll") for (int _i = 0; _i < 2; ++_i) \
        __builtin_amdgcn_global_load_lds((const unsigned*)((const char*)(gbase) + (voff)[_i]), (LAS unsigned*)(lds + (bufoff) + ldsw + _i * 8192), 16, 0, 0); } while (0)
#define PG8_LDA(dst, b, h) do { _Pragma("unroll") for (int m = 0; m < 4; ++m) _Pragma("unroll") for (int k = 0; k < 2; ++k) dst[m][k] = *(const LAS f16x8*)(lds + PG8_SA(b, h) + aoff + m * 2048 + k * 1024); } while (0)
#define PG8_LDB(dst, b, h) do { _Pragma("unroll") for (int n = 0; n < 2; ++n) _Pragma("unroll") for (int k = 0; k < 2; ++k) dst[n][k] = *(const LAS f16x8*)(lds + PG8_SB(b, h) + boff + n * 2048 + k * 1024); } while (0)
#define PG8_MMA(ai, bj, At, Bt) do { __builtin_amdgcn_s_setprio(1); _Pragma("unroll") for (int m = 0; m < 4; ++m) _Pragma("unroll") for (int n = 0; n < 2; ++n) _Pragma("unroll") for (int k = 0; k < 2; ++k) \
        acc[ai][bj][m][n] = __builtin_amdgcn_mfma_f32_16x16x32_f16(Bt[n][k], At[m][k], acc[ai][bj][m][n], 0, 0, 0); __builtin_amdgcn_s_setprio(0); } while (0)
#define PG8_WAIT_V(n) asm volatile("s_waitcnt vmcnt(" #n ")" ::: "memory")
#define PG8_WAIT_L(n) asm volatile("s_waitcnt lgkmcnt(" #n ")" ::: "memory")
#define PG8_BAR __builtin_amdgcn_s_barrier()
#define PG8_SCHED __builtin_amdgcn_sched_barrier(0)
    Unit cur, nxt; int ui = 0;
    if (!S.next(0, cur)) return;
    f32x4 acc[2][2][4][2];
#pragma unroll
    for (int a = 0; a < 2; ++a)
#pragma unroll
        for (int b = 0; b < 2; ++b)
#pragma unroll
            for (int m = 0; m < 4; ++m)
#pragma unroll
                for (int n = 0; n < 2; ++n) acc[a][b][m][n] = (f32x4){0.f, 0.f, 0.f, 0.f};
    f16x8 At[4][2], B0[2][2], B1[2][2];
    const char* cA = (const char*)g.A + (size_t)cur.pm * tstep; const char* cB = (const char*)g.Bt + (size_t)cur.pn * tstep;
    PG8_STAGE(PG8_SB(0, 0), cB, voffB); PG8_STAGE(PG8_SB(0, 1), cB + hstep, voffB); PG8_STAGE(PG8_SA(0, 0), cA, voffA); PG8_STAGE(PG8_SA(0, 1), cA + hstep, voffA);
    if (wr == 1) PG8_BAR;
    PG8_WAIT_V(2); PG8_BAR;
    PG8_STAGE(PG8_SB(1, 0), cB + kstep, voffB); PG8_STAGE(PG8_SA(1, 0), cA + kstep, voffA); PG8_STAGE(PG8_SB(1, 1), cB + hstep + kstep, voffB);
    PG8_WAIT_V(6); PG8_BAR;
    for (;;) {
        const bool has_next = S.next(ui + 1, nxt);
        const char* nA = has_next ? (const char*)g.A + (size_t)nxt.pm * tstep : cA; const char* nB = has_next ? (const char*)g.Bt + (size_t)nxt.pn * tstep : cB;
        for (int t = 0; t < nt; t += 2) {
            const bool last = (t == nt - 2);
            const char* a1 = cA + (size_t)(t + 1) * kstep;
            const char* a2 = last ? nA : cA + (size_t)(t + 2) * kstep; const char* b2 = last ? nB : cB + (size_t)(t + 2) * kstep;
            const char* a3 = a2 + kstep; const char* b3 = b2 + kstep;
            PG8_LDB(B0, 0, 0); PG8_LDB(B1, 0, 1); PG8_SCHED; PG8_LDA(At, 0, 0); PG8_STAGE(PG8_SA(1, 1), a1 + hstep, voffA);
            PG8_WAIT_V(8); PG8_WAIT_L(0); PG8_BAR; PG8_MMA(0, 0, At, B0); PG8_MMA(0, 1, At, B1); PG8_BAR; PG8_SCHED;
            PG8_LDA(At, 0, 1); PG8_STAGE(PG8_SB(0, 0), b2, voffB); PG8_STAGE(PG8_SB(0, 1), b2 + hstep, voffB); PG8_STAGE(PG8_SA(0, 0), a2, voffA);
            PG8_WAIT_V(8); PG8_WAIT_L(0); PG8_BAR; PG8_MMA(1, 0, At, B0); PG8_MMA(1, 1, At, B1); PG8_BAR; PG8_SCHED;
            PG8_LDB(B0, 1, 0); PG8_LDB(B1, 1, 1); PG8_SCHED; PG8_LDA(At, 1, 0); PG8_STAGE(PG8_SA(0, 1), a2 + hstep, voffA);
            PG8_WAIT_V(8); PG8_WAIT_L(0); PG8_BAR; PG8_MMA(0, 0, At, B0); PG8_MMA(0, 1, At, B1); PG8_BAR; PG8_SCHED;
            PG8_LDA(At, 1, 1); PG8_STAGE(PG8_SB(1, 0), b3, voffB); PG8_STAGE(PG8_SB(1, 1), b3 + hstep, voffB); PG8_STAGE(PG8_SA(1, 0), a3, voffA);
            PG8_WAIT_V(8); PG8_WAIT_L(0); PG8_BAR; PG8_MMA(1, 0, At, B0); PG8_MMA(1, 1, At, B1); PG8_BAR; PG8_SCHED;
        }
        if constexpr (ALIGN_EPI) { if (wr == 0) PG8_BAR; }
        E(acc, cur, wr, wc, fr, fq);
        if (!has_next) break;
#pragma unroll
        for (int a = 0; a < 2; ++a)
#pragma unroll
            for (int b = 0; b < 2; ++b)
#pragma unroll
                for (int m = 0; m < 4; ++m)
#pragma unroll
                    for (int n = 0; n < 2; ++n) acc[a][b][m][n] = (f32x4){0.f, 0.f, 0.f, 0.f};
        cur = nxt; cA = nA; cB = nB; ++ui;
        if constexpr (ALIGN_EPI) { if (wr == 1) PG8_BAR; }
    }
    PG8_WAIT_V(0);
    if constexpr (!ALIGN_EPI) { if (wr == 0) PG8_BAR; }
    PG8_BAR;
#undef PG8_SA
#undef PG8_SB
#undef PG8_STAGE
#undef PG8_LDA
#undef PG8_LDB
#undef PG8_MMA
#undef PG8_WAIT_V
#undef PG8_WAIT_L
#undef PG8_BAR
#undef PG8_SCHED
}
}

__device__ __forceinline__ f16x4 cvt4(f32x4 v) { return __builtin_convertvector(v, f16x4); }
__device__ __forceinline__ float silu_f(float x) { return x * __builtin_amdgcn_rcpf(1.0f + __expf(-x)); }
__device__ __forceinline__ float wave_sum(float v) {
#pragma unroll
    for (int o = 1; o < 64; o <<= 1) v += __shfl_xor(v, o);
    return v;
}


#define XB_TMO      128
#define XB_XCNT(j)  (256  + 64 * (j))
#define XB_XSUB(j)  (1280 + 64 * (j))
#define XB_XGEN(j)  (2304 + 64 * (j))
#define XB_TOP      3328
#define XB_TOPGEN   3392
#define XCD_BAR_WORDS 3456
#define XB_SPIN_CAP (1u << 18)
__device__ __forceinline__ unsigned xb_ld(unsigned* p)              { return __hip_atomic_load(p, __ATOMIC_RELAXED, __HIP_MEMORY_SCOPE_AGENT); }
__device__ __forceinline__ unsigned xb_add(unsigned* p, unsigned v) { return __hip_atomic_fetch_add(p, v, __ATOMIC_RELAXED, __HIP_MEMORY_SCOPE_AGENT); }
__device__ __forceinline__ unsigned xb_xcc_id() { return (unsigned)__builtin_amdgcn_s_getreg((3 << 11) | 20) & 0xFu; }
#define XB_SPIN(cond, bar) do { unsigned _sp = 0; while (cond) { __builtin_amdgcn_s_sleep(1); \
    if ((++_sp & 255u) == 0u) { if (xb_ld(&(bar)[XB_TMO])) break; if (_sp > XB_SPIN_CAP) { atomicAdd(&(bar)[XB_TMO], 1u); break; } } } } while (0)
struct XcdBarrier { unsigned* bar; unsigned x; volatile LAS unsigned* st; };
__device__ __forceinline__ XcdBarrier xcd_barrier_post(unsigned* bar, volatile LAS unsigned* st) {
    XcdBarrier b; b.bar = bar; b.x = xb_xcc_id(); b.st = st;
    if (threadIdx.x == 0) (void)xb_add(&bar[XB_XCNT(b.x)], 1u);
    return b;
}
__device__ __forceinline__ void xcd_barrier_complete(unsigned* bar, unsigned x, unsigned& nloc, unsigned& nx) {
    const unsigned G = gridDim.x * gridDim.y * gridDim.z;
    unsigned sum, cnt, mine, sp = 0u;
    for (;;) {
        sum = 0u; cnt = 0u; mine = 0u;
#pragma unroll
        for (unsigned j = 0; j < 16; ++j) { const unsigned c = xb_ld(&bar[XB_XCNT(j)]); sum += c; cnt += (c > 0u) ? 1u : 0u; mine = (j == x) ? c : mine; }
        if (sum == G) break;
        __builtin_amdgcn_s_sleep(1);
        if ((++sp & 255u) == 0u) { if (xb_ld(&bar[XB_TMO])) break; if (sp > XB_SPIN_CAP) { atomicAdd(&bar[XB_TMO], 1u); break; } }
    }
    nloc = mine > 0u ? mine : 1u; nx = cnt > 0u ? cnt : 1u;
}
__device__ __forceinline__ void xcd_barrier(const XcdBarrier& b) {
    asm volatile("s_waitcnt vmcnt(0)" ::: "memory");
    __syncthreads();
    if (threadIdx.x == 0) {
        unsigned* bar = b.bar;
        __builtin_amdgcn_s_waitcnt(0);
        unsigned nloc = b.st[0], nx = b.st[1];
        if (nloc == 0u) { xcd_barrier_complete(bar, b.x, nloc, nx); b.st[0] = nloc; b.st[1] = nx; }
        const unsigned old = xb_add(&bar[XB_XSUB(b.x)], 1u);
        const unsigned gen = old / nloc;
        if (old + 1u == (gen + 1u) * nloc) {
            __builtin_amdgcn_fence(__ATOMIC_RELEASE, "agent");
            asm volatile("s_waitcnt vmcnt(0)" ::: "memory");
            const unsigned og = xb_add(&bar[XB_TOP], 1u);
            const unsigned tg = og / nx;
            if (og + 1u == (tg + 1u) * nx) xb_add(&bar[XB_TOPGEN], 1u);
            else XB_SPIN(xb_ld(&bar[XB_TOPGEN]) == tg, bar);
            __builtin_amdgcn_fence(__ATOMIC_ACQUIRE, "agent");
            xb_add(&bar[XB_XGEN(b.x)], 1u);
            asm volatile("s_waitcnt vmcnt(0)" ::: "memory");
        } else {
            XB_SPIN(xb_ld(&bar[XB_XGEN(b.x)]) == gen, bar);
            __builtin_amdgcn_fence(__ATOMIC_ACQUIRE, "agent");
            asm volatile("s_waitcnt vmcnt(0)" ::: "memory");
        }
    }
    __syncthreads();
}

struct Params {
    const float *x, *norm_gain, *w_in, *w_pool, *b_pool, *pool_scale, *w_out, *final_gain;
    float* out; unsigned char* ws; int ph_lo, ph_hi;
};

struct EpiProj {
    static constexpr bool PERM = true;
    unsigned char* ws; const float* rope; float* kmean;
    __device__ __forceinline__ void operator()(const f32x4 (&acc)[2][2][4][2], const pg8::Unit& u, int wr, int wc, int fr, int fq) const {
        const int sec = u.pn >> 1;
        const int row0 = u.pm * 256 + wr * 64 + fr;
        const int colsec = (u.pn & 1) * 256 + wc * 32 + 8 * fq;
        const int b = u.pm >> 5;
#ifndef EP_MASK
#define EP_MASK 7
#endif
        if ((EP_MASK & 1) && sec <= 1) {
            h16* dstb = (h16*)(ws + WS_Q + (size_t)sec * (WS_K - WS_Q)); const float sc = sec == 0 ? QSCALE : 1.0f;
#pragma unroll
            for (int bj = 0; bj < 2; ++bj) {
                const int col = colsec + bj * 128, head = col >> 6, g4 = ((col & 63) >> 3) * 4;
                f32x4 cs1 = {0.f, 0.f, 0.f, 0.f}, cs2 = {0.f, 0.f, 0.f, 0.f};
#pragma unroll
                for (int ai = 0; ai < 2; ++ai)
#pragma unroll
                    for (int m = 0; m < 4; ++m) {
                        const int row = row0 + ai * 128 + m * 16, s = row & (SEQ - 1);
                        const unsigned ro = (unsigned)(s * 64 + g4);
                        const f32x4 co = *(const f32x4*)(rope + ro), si = *(const f32x4*)(rope + ro + 32u);
                        const f32x4 x1 = acc[ai][bj][m][0], x2 = acc[ai][bj][m][1];
                        const f32x4 o1 = x1 * co - x2 * si, o2 = x2 * co + x1 * si;
                        cs1 += o1; cs2 += o2;
                        const unsigned dof = (unsigned)(((b * NH + head) * SEQ + s) * HD + g4);
                        *(f16x4*)(dstb + dof) = cvt4(o1 * sc); *(f16x4*)(dstb + dof + 32u) = cvt4(o2 * sc);
                        if (m & 1) asm volatile("" ::: "memory");
                    }
                if (sec == 1) {
#pragma unroll
                    for (int i = 0; i < 4; ++i) {
#pragma unroll
                        for (int o = 1; o < 16; o <<= 1) { cs1[i] += __shfl_xor(cs1[i], o); cs2[i] += __shfl_xor(cs2[i], o); }
                    }
                    if (fr == 0) {
                        float* km = kmean + ((size_t)(b * NH + head) * NBLK + (u.pm & 31)) * HD;
#pragma unroll
                        for (int i = 0; i < 4; ++i) { atomicAdd(km + g4 + i, cs1[i] * (1.0f / 256.0f)); atomicAdd(km + 32 + g4 + i, cs2[i] * (1.0f / 256.0f)); }
                    }
                }
            }
        } else if ((EP_MASK & 2) && sec == 2) {
#pragma unroll
            for (int bj = 0; bj < 2; ++bj) {
                const int col = colsec + bj * 128, head = col >> 6, d0 = col & 63;
                h16* vb = (h16*)(ws + WS_VT); const unsigned vo0 = (unsigned)(((b * NH + head) * HD + d0) * SEQ);
#pragma unroll
                for (int ai = 0; ai < 2; ++ai)
#pragma unroll
                    for (int m = 0; m < 4; ++m) {
                        const int row = row0 + ai * 128 + m * 16, s = row & (SEQ - 1);
#pragma unroll
                        for (int n = 0; n < 2; ++n)
#pragma unroll
                            for (int i = 0; i < 4; ++i) vb[vo0 + (unsigned)((4 * n + i) * SEQ + s)] = (h16)acc[ai][bj][m][n][i];
                        if (m & 1) asm volatile("" ::: "memory");
                    }
            }
        } else if (EP_MASK & 4) {
            h16* dstb = (h16*)(ws + WS_SG + (size_t)(sec - 3) * (WS_Z - WS_SG));
#pragma unroll
            for (int bj = 0; bj < 2; ++bj) {
                const int col = colsec + bj * 128;
#pragma unroll
                for (int ai = 0; ai < 2; ++ai)
#pragma unroll
                    for (int m = 0; m < 4; ++m) {
                        const int row = row0 + ai * 128 + m * 16;
                        const f32x4 a0 = acc[ai][bj][m][0], a1 = acc[ai][bj][m][1];
                        const f32x4 s0 = {silu_f(a0[0]), silu_f(a0[1]), silu_f(a0[2]), silu_f(a0[3])}, s1 = {silu_f(a1[0]), silu_f(a1[1]), silu_f(a1[2]), silu_f(a1[3])};
                        const f16x4 a = cvt4(sec != 4 ? s0 : a0), c = cvt4(sec != 4 ? s1 : a1);
                        f16x8 o = {a[0], a[1], a[2], a[3], c[0], c[1], c[2], c[3]};
                        *(f16x8*)(dstb + (unsigned)(row * AW + col)) = o;
                    }
            }
        }
    }
};

struct EpiRes {
    static constexpr bool PERM = false;
    const float* x; float* out; float* rowss;
    __device__ __forceinline__ void operator()(const f32x4 (&acc)[2][2][4][2], const pg8::Unit& u, int wr, int wc, int fr, int fq) const {
        const int row0 = u.pm * 256 + wr * 64 + fr, col0 = u.pn * 256 + wc * 32 + 4 * fq;
#pragma unroll
        for (int ai = 0; ai < 2; ++ai)
#pragma unroll
            for (int m = 0; m < 4; ++m) {
                const int row = row0 + ai * 128 + m * 16; float ss = 0.f;
#pragma unroll
                for (int bj = 0; bj < 2; ++bj)
#pragma unroll
                    for (int n = 0; n < 2; ++n) {
                        const size_t off = (size_t)row * DM + col0 + bj * 128 + n * 16;
                        const f32x4 y = *(const f32x4*)(x + off) + acc[ai][bj][m][n];
                        *(f32x4*)(out + off) = y; ss += (y[0] * y[0] + y[1] * y[1]) + (y[2] * y[2] + y[3] * y[3]);
                    }
                ss += __shfl_xor(ss, 16); ss += __shfl_xor(ss, 32);
                if (fq == 0) rowss[(size_t)row * 16 + u.pn * 4 + wc] = ss;
            }
    }
};

__device__ __forceinline__ void p0_transpose_item(const float* W, int ldw, h16* WT, int n0, int k0, bool qkperm, LAS float* scr, int lane) {
    const int np = n0 + (lane & 31);
    int nl = np;
    if (qkperm) { const int p = np & 63, g = p >> 3, i = p & 7; nl = (np & ~63) + 4 * g + (i & 3) + 32 * (i >> 2); }
#pragma unroll 8
    for (int i = 0; i < 32; ++i) { const int kk = 2 * i + (lane >> 5); scr[kk * 33 + (lane & 31)] = W[(size_t)(k0 + kk) * ldw + nl]; }
    asm volatile("s_waitcnt lgkmcnt(0)" ::: "memory");
    const int c = lane & 7;
#pragma unroll
    for (int j = 0; j < 4; ++j) { const int n = (lane >> 3) + 8 * j; const LAS float* s = scr + (8 * c) * 33 + n;
        f16x8 o = {(h16)s[0 * 33], (h16)s[1 * 33], (h16)s[2 * 33], (h16)s[3 * 33], (h16)s[4 * 33], (h16)s[5 * 33], (h16)s[6 * 33], (h16)s[7 * 33]};
        *(f16x8*)(WT + (size_t)(n0 + n) * DM + k0 + 8 * c) = o; }
    asm volatile("s_waitcnt lgkmcnt(0)" ::: "memory");
}

__device__ __forceinline__ void sincos_d(double x, float& c, float& s) {
    const double n = __builtin_rint(x * 0.63661977236758134308);
    double r = __builtin_fma(-n, 1.5707963267948966, x); r = __builtin_fma(-n, 6.123233995736766e-17, r);
    const double r2 = r * r;
    double sp = -1.0 / 39916800.0; sp = sp * r2 + 1.0 / 362880.0; sp = sp * r2 - 1.0 / 5040.0; sp = sp * r2 + 1.0 / 120.0; sp = sp * r2 - 1.0 / 6.0; const double sn = r + r * r2 * sp;
    double cp = 1.0 / 479001600.0; cp = cp * r2 - 1.0 / 3628800.0; cp = cp * r2 + 1.0 / 40320.0; cp = cp * r2 - 1.0 / 720.0; cp = cp * r2 + 1.0 / 24.0; cp = cp * r2 - 0.5; const double cn = 1.0 + r2 * cp;
    const int q = ((int)n) & 3;
    const double ss = (q & 1) ? cn : sn, cc = (q & 1) ? sn : cn;
    s = (float)((q & 2) ? -ss : ss); c = (float)(((q + 1) & 2) ? -cc : cc);
}

__device__ __forceinline__ void p0_prologue(const Params& P, LAS unsigned char* lds) {
    const int tid = threadIdx.x, lane = tid & 63, wave = tid >> 6, bid = blockIdx.x, G = gridDim.x;
    unsigned char* ws = P.ws;
    { int* cnt = (int*)(ws + WS_CNT); float* km = (float*)(ws + WS_KMEAN);
      for (int i = bid * 512 + tid; i < 512 + 16 * NBLK * HD; i += G * 512) { if (i < 512) cnt[i] = 0; else km[i - 512] = 0.f; } }
    const int NFB = G >= 128 ? 64 : G;
    if (bid < NFB) {
        LAS float* A = (LAS float*)lds; LAS float* Wp = (LAS float*)(lds + 34816);
        for (int fi = bid; fi < 64; fi += NFB) {
            const int k0 = (fi >> 2) * 64, g = fi & 3;
            for (int i = 0; i < 16; ++i) { const int idx = tid + 512 * i, kk = idx >> 7, j = idx & 127; A[kk * 132 + j] = P.w_in[(size_t)(k0 + kk) * NIN + 2048 + 128 * g + j]; }
            for (int i = 0; i < 32; ++i) { const int idx = tid + 512 * i; Wp[idx] = P.w_pool[(size_t)g * 16384 + idx]; }
            __syncthreads();
            const int cc = tid & 127, kq = tid >> 7;
            float a[16];
#pragma unroll
            for (int r = 0; r < 16; ++r) a[r] = 0.f;
            for (int j4 = 0; j4 < 32; ++j4) {
                const float w0 = Wp[(4 * j4 + 0) * 128 + cc], w1 = Wp[(4 * j4 + 1) * 128 + cc], w2 = Wp[(4 * j4 + 2) * 128 + cc], w3 = Wp[(4 * j4 + 3) * 128 + cc];
#pragma unroll
                for (int r = 0; r < 16; ++r) { const f32x4 av = *(const LAS f32x4*)(A + (kq * 16 + r) * 132 + 4 * j4); a[r] += av[0] * w0 + av[1] * w1 + av[2] * w2 + av[3] * w3; }
            }
            h16* dst = (h16*)(ws + WS_WTIN) + (size_t)(2048 + 128 * g + cc) * DM + k0 + kq * 16;
            f16x8 o0 = {(h16)a[0], (h16)a[1], (h16)a[2], (h16)a[3], (h16)a[4], (h16)a[5], (h16)a[6], (h16)a[7]};
            f16x8 o1 = {(h16)a[8], (h16)a[9], (h16)a[10], (h16)a[11], (h16)a[12], (h16)a[13], (h16)a[14], (h16)a[15]};
            *(f16x8*)dst = o0; *(f16x8*)(dst + 8) = o1;
            __syncthreads();
        }
    }
    if (bid >= NFB || G < 128) {
        const int NTB = G >= 128 ? G - NFB : G, tb = G >= 128 ? bid - NFB : bid;
        LAS float* scr = (LAS float*)(lds + wave * 16384);
        const int gw = tb * 8 + wave, NGW = NTB * 8;
        for (int it = gw; it < 16 * 80 + 16 * 32; it += NGW) {
            if (it < 16 * 80) { const int kb = it / 80, nb = it % 80, nbp = nb < 64 ? nb : nb + 16;
                p0_transpose_item(P.w_in, NIN, (h16*)(ws + WS_WTIN), nbp * 32, kb * 64, nbp < 32, scr, lane); }
            else { const int r = it - 16 * 80, kb = r / 32, nb = r % 32;
                p0_transpose_item(P.w_out, DM, (h16*)(ws + WS_WTOUT), nb * 32, kb * 64, false, scr, lane); }
        }
        float* rope = (float*)(ws + WS_ROPE);
        for (int i = tb * 512 + tid; i < SEQ * 32; i += NTB * 512) {
            const int s = i >> 5, j = i & 31; const float ang = (float)s * c_inv_freq[j];
            float c, sn; sincos_d((double)ang, c, sn); rope[(size_t)s * 64 + j] = c; rope[(size_t)s * 64 + 32 + j] = sn;
        }
    }
    {
        const int nb = G, b0 = bid;
        {
            f32x4 gn[4];
#pragma unroll
            for (int j = 0; j < 4; ++j) gn[j] = *((const f32x4*)P.norm_gain + lane + 64 * j);
            h16* H = (h16*)(ws + WS_H);
            for (int m = b0 * 8 + wave; m < MROWS; m += nb * 8) {
                const f32x4* xr = (const f32x4*)(P.x + (size_t)m * DM) + lane;
                f32x4 v[4]; float ss = 0.f;
#pragma unroll
                for (int j = 0; j < 4; ++j) { v[j] = xr[64 * j]; ss += (v[j][0] * v[j][0] + v[j][1] * v[j][1]) + (v[j][2] * v[j][2] + v[j][3] * v[j][3]); }
                const float rstd = 1.0f / sqrtf(wave_sum(ss) * (1.0f / DM) + EPS);
#pragma unroll
                for (int j = 0; j < 4; ++j) *(f16x4*)(H + (size_t)m * DM + 4 * lane + 256 * j) = cvt4(v[j] * rstd * gn[j]);
            }
        }
    }
}

__device__ __forceinline__ void p2_gate(const Params& P, LAS unsigned char* lds) {
    const int tid = threadIdx.x, lane = tid & 63, wave = tid >> 6, G = gridDim.x;
    unsigned char* ws = P.ws;
    const h16* Q = (const h16*)(ws + WS_Q); const float* kmean = (const float*)(ws + WS_KMEAN);
    int* cnt = (int*)(ws + WS_CNT); int* list = (int*)(ws + WS_LIST);
    LAS float* kml = (LAS float*)lds;
    for (int it0 = blockIdx.x * 8; it0 < 16 * 128; it0 += G * 8) {
        const int bh = it0 >> 7;
        __syncthreads();
        *(LAS f32x4*)(kml + tid * 4) = *(const f32x4*)(kmean + (size_t)bh * NBLK * HD + tid * 4);
        __syncthreads();
        const int it = it0 + wave, s0 = (it & 127) * 64, blk = __builtin_amdgcn_readfirstlane(s0 >> 8);
        if (blk == 0) continue;
        const int s = s0 + lane;
        float qf[64];
        { const f16x8* qp = (const f16x8*)(Q + ((size_t)bh * SEQ + s) * HD);
#pragma unroll
          for (int c = 0; c < 8; ++c) { const f16x8 v = qp[c];
#pragma unroll
              for (int i = 0; i < 8; ++i) qf[8 * c + i] = (float)v[i]; } }
        float v0 = -INFINITY, v1 = -INFINITY, v2 = -INFINITY; int i0 = 0, i1 = 1, i2 = 2;
        for (int n = 0; n < blk; ++n) {
            const LAS float* km = kml + n * HD;
            float ga = 0.f, gb = 0.f;
#pragma unroll
            for (int d = 0; d < 64; d += 4) { const f32x4 kv = *(const LAS f32x4*)(km + d); ga += qf[d] * kv[0]; gb += qf[d + 1] * kv[1]; ga += qf[d + 2] * kv[2]; gb += qf[d + 3] * kv[3]; }
            const float gt = ga + gb;
            if (gt > v0) { v2 = v1; i2 = i1; v1 = v0; i1 = i0; v0 = gt; i0 = n; }
            else if (gt > v1) { v2 = v1; i2 = i1; v1 = gt; i1 = n; }
            else if (gt > v2) { v2 = gt; i2 = n; }
        }
        const int nsel = blk < 3 ? blk : 3;
        int r0 = 0, r1 = 0, r2 = 0, mycount = 0;
        const unsigned long long lt = (1ull << lane) - 1ull;
        for (int n = 0; n < blk; ++n) {
            const bool h0 = (i0 == n), h1 = (nsel > 1 && i1 == n), h2 = (nsel > 2 && i2 == n);
            const unsigned long long mask = __ballot(h0 || h1 || h2);
            const int rank = __popcll(mask & lt);
            if (h0) r0 = rank; if (h1) r1 = rank; if (h2) r2 = rank;
            if (lane == n) mycount = __popcll(mask);
        }
        int base = 0;
        if (lane < blk && mycount > 0) base = atomicAdd(cnt + bh * NBLK + lane, mycount);
        { const int b0 = __shfl(base, i0); list[((size_t)bh * NBLK + i0) * SEQ + b0 + r0] = s; }
        if (nsel > 1) { const int b1 = __shfl(base, i1); list[((size_t)bh * NBLK + i1) * SEQ + b1 + r1] = s | (1 << 13); }
        if (nsel > 2) { const int b2 = __shfl(base, i2); list[((size_t)bh * NBLK + i2) * SEQ + b2 + r2] = s | (2 << 13); }
    }
}

constexpr int KLD = 144, VLD = 520;
constexpr int LDS_KOFF = 0, LDS_VOFF = 256 * KLD;
__device__ __forceinline__ int crow(int r, int hi) { return (r & 3) + 8 * (r >> 2) + 4 * hi; }

template <bool OWN>
__device__ __forceinline__ void attn_unit(const Params& P, LAS unsigned char* lds, int bh, int n, const int* lst, int count) {
    const int tid = threadIdx.x, lane = tid & 63, wave = __builtin_amdgcn_readfirstlane(tid >> 6), r32 = lane & 31, hi = lane >> 5;
    unsigned char* ws = P.ws;
    const h16* Q = (const h16*)(ws + WS_Q); const h16* K = (const h16*)(ws + WS_K); const h16* Vt = (const h16*)(ws + WS_VT);
    {
        const u32x4* kg = (const u32x4*)(K + ((size_t)bh * SEQ + (size_t)n * BLK) * HD);
#pragma unroll
        for (int i = 0; i < 4; ++i) { const int ch = tid + 512 * i; const u32x4 v = kg[ch]; *(LAS u32x4*)(lds + LDS_KOFF + (ch >> 3) * KLD + (ch & 7) * 16) = v; }
#pragma unroll
        for (int i = 0; i < 4; ++i) { const int ch = tid + 512 * i, d = ch >> 5, c16 = ch & 31;
            const u32x4 v = *(const u32x4*)(Vt + ((size_t)bh * HD + d) * SEQ + (size_t)n * BLK + c16 * 8);
            LAS u32x2* dst = (LAS u32x2*)(lds + LDS_VOFF + d * VLD + c16 * 16); dst[0] = (u32x2){v[0], v[1]}; dst[1] = (u32x2){v[2], v[3]}; }
    }
    int s, kslot = 3; bool valid;
    if (OWN) { s = n * BLK + wave * 32 + r32; valid = true; }
    else { int idx = wave * 32 + r32; valid = idx < count; if (!valid) idx = count - 1; const int e = lst[idx]; s = e & 8191; kslot = e >> 13; }
    const bool wave_active = OWN ? true : (wave * 32 < count);
    f16x8 qf[4];
    { const f16x8* qp = (const f16x8*)(Q + ((size_t)bh * SEQ + s) * HD);
#pragma unroll
      for (int d0 = 0; d0 < 4; ++d0) qf[d0] = qp[2 * d0 + hi]; }
    __syncthreads();
    if (wave_active) {
        f32x16 S[8];
#pragma unroll
        for (int kt = 0; kt < 8; ++kt) {
            if (!OWN || kt <= wave) {
                f32x16 a = {};
#pragma unroll
                for (int d0 = 0; d0 < 4; ++d0) {
                    const f16x8 kf = *(const LAS f16x8*)(lds + LDS_KOFF + (32 * kt + r32) * KLD + 32 * d0 + 16 * hi);
                    a = __builtin_amdgcn_mfma_f32_32x32x16_f16(kf, qf[d0], a, 0, 0, 0);
                }
                if (OWN && kt == wave) {
#pragma unroll
                    for (int r = 0; r < 16; ++r) if (crow(r, hi) > r32) a[r] = -INFINITY;
                }
                S[kt] = a;
            }
        }
        float mx = -INFINITY;
#pragma unroll
        for (int kt = 0; kt < 8; ++kt) if (!OWN || kt <= wave) {
#pragma unroll
            for (int r = 0; r < 16; ++r) mx = fmaxf(mx, S[kt][r]);
        }
        mx = fmaxf(mx, __shfl_xor(mx, 32));
        float l = 0.f;
        f32x16 O[2]; O[0] = (f32x16){}; O[1] = (f32x16){};
#pragma unroll
        for (int kt = 0; kt < 8; ++kt) if (!OWN || kt <= wave) {
            f32x16 p = S[kt];
#pragma unroll
            for (int r = 0; r < 16; ++r) { p[r] = __builtin_amdgcn_exp2f(p[r] - mx); l += p[r]; }
#pragma unroll
            for (int st = 0; st < 2; ++st) {
                const f16x4 pa = cvt4((f32x4){p[8 * st], p[8 * st + 1], p[8 * st + 2], p[8 * st + 3]}), pb = cvt4((f32x4){p[8 * st + 4], p[8 * st + 5], p[8 * st + 6], p[8 * st + 7]});
                const f16x8 pf = {pa[0], pa[1], pa[2], pa[3], pb[0], pb[1], pb[2], pb[3]};
#pragma unroll
                for (int d1 = 0; d1 < 2; ++d1) {
                    const LAS unsigned char* vp = lds + LDS_VOFF + (32 * d1 + r32) * VLD + (32 * kt + 16 * st + 4 * hi) * 2;
                    const f16x4 va = *(const LAS f16x4*)vp, vb = *(const LAS f16x4*)(vp + 16);
                    const f16x8 vf = {va[0], va[1], va[2], va[3], vb[0], vb[1], vb[2], vb[3]};
                    O[d1] = __builtin_amdgcn_mfma_f32_32x32x16_f16(vf, pf, O[d1], 0, 0, 0);
                }
            }
        }
        l += __shfl_xor(l, 32);
        const float rl = 1.0f / l;
        if (!OWN) {
            if (valid) {
                h16* op = (h16*)(ws + WS_OPART) + (((size_t)bh * SEQ + s) * 3 + kslot) * HD;
#pragma unroll
                for (int d1 = 0; d1 < 2; ++d1)
#pragma unroll
                    for (int g = 0; g < 4; ++g)
                        *(f16x4*)(op + 32 * d1 + 8 * g + 4 * hi) = cvt4((f32x4){O[d1][4 * g] * rl, O[d1][4 * g + 1] * rl, O[d1][4 * g + 2] * rl, O[d1][4 * g + 3] * rl});
                if (hi == 0) ((float*)(ws + WS_LSE))[((size_t)bh * SEQ + s) * 4 + kslot] = mx + log2f(l);
            }
        } else {
            const int nsel = n < 3 ? n : 3;
            const float lse_own = mx + log2f(l);
            float lk[3] = {-INFINITY, -INFINITY, -INFINITY};
            const float* lsep = (const float*)(ws + WS_LSE) + ((size_t)bh * SEQ + s) * 4;
#pragma unroll
            for (int k = 0; k < 3; ++k) if (k < nsel) lk[k] = lsep[k];
            const float M = fmaxf(fmaxf(lse_own, lk[0]), fmaxf(lk[1], lk[2]));
            const float w_own = __builtin_amdgcn_exp2f(lse_own - M);
            float wk[3]; float den = w_own;
#pragma unroll
            for (int k = 0; k < 3; ++k) { wk[k] = __builtin_amdgcn_exp2f(lk[k] - M); den += wk[k]; }
            const float rden = 1.0f / den, so = w_own * rl * rden;
            const int b = bh >> 3, head = bh & 7; const size_t row = (size_t)b * SEQ + s;
            const h16* op = (const h16*)(ws + WS_OPART) + ((size_t)bh * SEQ + s) * 3 * HD;
            const h16* sg = (const h16*)(ws + WS_SG) + row * AW + head * HD;
            h16* mix = (h16*)(ws + WS_MIX) + row * DM + head * HD;
#pragma unroll
            for (int d1 = 0; d1 < 2; ++d1)
#pragma unroll
                for (int g = 0; g < 4; ++g) {
                    const int d = 32 * d1 + 8 * g + 4 * hi;
                    f32x4 o = {O[d1][4 * g] * so, O[d1][4 * g + 1] * so, O[d1][4 * g + 2] * so, O[d1][4 * g + 3] * so};
#pragma unroll
                    for (int k = 0; k < 3; ++k) if (k < nsel) { const f16x4 pv = *(const f16x4*)(op + k * HD + d); const float w = wk[k] * rden;
                        o[0] += w * (float)pv[0]; o[1] += w * (float)pv[1]; o[2] += w * (float)pv[2]; o[3] += w * (float)pv[3]; }
                    const f16x4 gv = *(const f16x4*)(sg + d);
                    o[0] *= (float)gv[0]; o[1] *= (float)gv[1]; o[2] *= (float)gv[2]; o[3] *= (float)gv[3];
                    *(f16x4*)(mix + d) = cvt4(o);
                }
        }
    }
    __syncthreads();
}

__device__ __forceinline__ void p3_selected(const Params& P, LAS unsigned char* lds, int nrep) {
    const int tid = threadIdx.x, G = gridDim.x;
    LAS int* pref = (LAS int*)(lds + 73728);
    LAS int* cntl = (LAS int*)(lds + 73728 + 4096);
    const int* cnt = (const int*)(P.ws + WS_CNT);
    const int c = cnt[tid]; cntl[tid] = c;
    int v = (c + 255) >> 8;
    LAS int* sc = (LAS int*)(lds + 73728 + 8192);
    sc[tid] = v; __syncthreads();
    int pp = 0;
    for (int o = 1; o < 512; o <<= 1) { const int a = sc[pp * 512 + tid] + (tid >= o ? sc[pp * 512 + tid - o] : 0); sc[(pp ^ 1) * 512 + tid] = a; pp ^= 1; __syncthreads(); }
    pref[tid + 1] = sc[pp * 512 + tid]; if (tid == 0) pref[0] = 0;
    __syncthreads();
    const int NU = pref[512];
    for (int uu = blockIdx.x; uu < NU * nrep; uu += G) {
        const int u = uu % NU;
        int lo = 0, hi = 512;
        while (hi - lo > 1) { const int mid = (lo + hi) >> 1; if (pref[mid] <= u) lo = mid; else hi = mid; }
        const int ch = u - pref[lo], bh = lo >> 5, n = lo & 31;
        int count = cntl[lo] - ch * 256; count = count > 256 ? 256 : count;
        attn_unit<false>(P, lds, bh, n, (const int*)(P.ws + WS_LIST) + (size_t)lo * SEQ + ch * 256, count);
    }
}

template <int W>
__device__ __forceinline__ void pool_item(const Params& P, int row0, int c0) {
    unsigned char* ws = P.ws;
    const h16* Z = (const h16*)(ws + WS_Z); const h16* SGP = (const h16*)(ws + WS_SGP); h16* MIX = (h16*)(ws + WS_MIX);
    const int s0 = row0 & (SEQ - 1);
    f16x8 zs[W + 7];
#pragma unroll
    for (int i = 0; i < W + 7; ++i) { const int t = s0 - (W - 1) + i; zs[i] = (f16x8){}; if (t >= 0) zs[i] = *(const f16x8*)(Z + (size_t)(row0 - (W - 1) + i) * AW + c0); }
    f16x8 gv[8];
#pragma unroll
    for (int j = 0; j < 8; ++j) gv[j] = *(const f16x8*)(SGP + (size_t)(row0 + j) * AW + c0);
    float bp[8], ps[8];
#pragma unroll
    for (int c = 0; c < 8; ++c) { bp[c] = P.b_pool[c0 + c]; ps[c] = P.pool_scale[c0 + c]; }
    float sum[8];
#pragma unroll
    for (int c = 0; c < 8; ++c) { float a = 0.f;
#pragma unroll
        for (int i = 0; i < W; ++i) a += (float)zs[i][c];
        sum[c] = a; }
#pragma unroll
    for (int j = 0; j < 8; ++j) {
        if (j > 0) {
#pragma unroll
            for (int c = 0; c < 8; ++c) sum[c] += (float)zs[j + W - 1][c] - (float)zs[j - 1][c];
        }
        const int sj = s0 + j; const float rc = 1.0f / (float)((sj + 1) < W ? (sj + 1) : W);
        f16x8 o;
#pragma unroll
        for (int c = 0; c < 8; ++c) o[c] = (h16)((sum[c] * rc - (float)zs[j + W - 1][c] + bp[c]) * ps[c] * (float)gv[j][c]);
        *(f16x8*)(MIX + (size_t)(row0 + j) * DM + AW + c0) = o;
    }
}

__device__ __forceinline__ void p4_own_pool(const Params& P, LAS unsigned char* lds, int nrep, int nrep_pool) {
    const int tid = threadIdx.x, G = gridDim.x;
    for (int uu = blockIdx.x; uu < 16 * NBLK * nrep; uu += G) {
        const int u = uu % (16 * NBLK);
        const int bh = u & 15, n = 31 - (u >> 4);
        attn_unit<true>(P, lds, bh, n, nullptr, 256);
    }
    for (int wj = blockIdx.x * 8 + (tid >> 6); wj < 4 * 512 * nrep_pool; wj += G * 8) {
        const int wi = wj % (4 * 512);
        const int g = __builtin_amdgcn_readfirstlane(wi & 3), lane = tid & 63;
        const int row0 = ((wi >> 2) * 4 + (lane >> 4)) * 8, c0 = g * 128 + (lane & 15) * 8;
        if (g == 0) pool_item<2>(P, row0, c0); else if (g == 1) pool_item<4>(P, row0, c0); else if (g == 2) pool_item<8>(P, row0, c0); else pool_item<16>(P, row0, c0);
    }
}

__device__ __forceinline__ void p6_final(const Params& P) {
    const int tid = threadIdx.x, lane = tid & 63, wave = tid >> 6, G = gridDim.x;
    const float* rowss = (const float*)(P.ws + WS_ROWSS);
    f32x4 gn[4];
#pragma unroll
    for (int j = 0; j < 4; ++j) gn[j] = *((const f32x4*)P.final_gain + lane + 64 * j);
    for (int m = blockIdx.x * 8 + wave; m < MROWS; m += G * 8) {
        float ss = rowss[(size_t)m * 16 + (lane & 15)];
#pragma unroll
        for (int o = 1; o < 16; o <<= 1) ss += __shfl_xor(ss, o);
        const float rstd = 1.0f / sqrtf(ss * (1.0f / DM) + EPS);
        f32x4* yr = (f32x4*)(P.out + (size_t)m * DM) + lane;
#pragma unroll
        for (int j = 0; j < 4; ++j) { const f32x4 v = yr[64 * j]; yr[64 * j] = v * rstd * gn[j]; }
    }
}

__global__ void __launch_bounds__(512, 2) hymba_fwd(Params P) {
    extern __shared__ __attribute__((aligned(16))) unsigned char lds_raw[];
    LAS unsigned char* lds = (LAS unsigned char*)lds_raw;
    cg::grid_group grid = cg::this_grid();
    unsigned char* ws = P.ws;
    const int lo = P.ph_lo, hi = P.ph_hi;
#ifndef PHASE_MASK
#define PHASE_MASK 0x7f
#endif
#define IN(k) (((PHASE_MASK >> (k)) & 1) && lo <= (k) && (k) < hi)
#define SEAM(k) do { if (IN(k) && IN((k) + 1)) xcd_barrier(xbar); } while (0)
    volatile LAS unsigned* bst = (volatile LAS unsigned*)(lds + 131072 + 512);
    if (threadIdx.x < 2) bst[threadIdx.x] = 0u;
    __syncthreads();
    XcdBarrier xbar = xcd_barrier_post((unsigned*)(ws + WS_BAR), bst);
    if (P.ph_lo < 0) grid.sync();
#ifndef REP_MASK
#define REP_MASK 0
#endif
#ifndef EXTRA_SYNCS
#define EXTRA_SYNCS 0
#endif
#define REPS(k) (1 + ((REP_MASK >> (k)) & 1))
    for (int i = 0; i < EXTRA_SYNCS; ++i) xcd_barrier(xbar);
    _Pragma("unroll") for (int rep = 0; rep < REPS(0); ++rep)
    if (IN(0)) p0_prologue(P, lds);
    SEAM(0);
    if (IN(1)) {
        pg8::Gemm g{(const h16*)(ws + WS_H), (const h16*)(ws + WS_WTIN), MROWS, NIN, DM}; pg8::StaticOrder S; S.init(MROWS, NIN, (int)gridDim.x, (int)blockIdx.x, REPS(1));
        EpiProj E{ws, (const float*)(ws + WS_ROPE), (float*)(ws + WS_KMEAN)};
        pg8::gemm_phase<EpiProj, true>(lds, g, S, E);
    }
    SEAM(1);
    if (IN(2)) p2_gate(P, lds);
    SEAM(2);
    if (IN(3)) p3_selected(P, lds, REPS(3));
    SEAM(3);
    if (IN(4)) p4_own_pool(P, lds, REPS(4), REPS(7));
    SEAM(4);
    if (IN(5)) {
        pg8::Gemm g{(const h16*)(ws + WS_MIX), (const h16*)(ws + WS_WTOUT), MROWS, DM, DM}; pg8::StaticOrder S; S.init(MROWS, DM, (int)gridDim.x, (int)blockIdx.x, REPS(5));
        EpiRes E{P.x, P.out, (float*)(ws + WS_ROWSS)};
        pg8::gemm_phase<EpiRes, true>(lds, g, S, E);
    }
    SEAM(5);
    if (IN(6)) p6_final(P);
#undef IN
#undef SEAM
}

#ifndef N_LAUNCHES
#define N_LAUNCHES 1
#endif

extern "C" void kernel_launch(void* const* d_in, const int* in_sizes, int n_in, void* d_out, int out_size, void* d_ws, size_t ws_size, hipStream_t stream) {
    static int grid = 0;
    if (grid == 0) {
        int dev = 0, cus = 0, per_cu = 0;
        (void)hipGetDevice(&dev);
        (void)hipDeviceGetAttribute(&cus, hipDeviceAttributeMultiprocessorCount, dev);
        if (hipFuncSetAttribute((const void*)hymba_fwd, hipFuncAttributeMaxDynamicSharedMemorySize, LDS_BYTES) != hipSuccess) fprintf(stderr, "kernel_launch: hipFuncSetAttribute failed\n");
        if (hipOccupancyMaxActiveBlocksPerMultiprocessor(&per_cu, (const void*)hymba_fwd, 512, LDS_BYTES) != hipSuccess || per_cu < 1) { fprintf(stderr, "kernel_launch: occupancy query says %d\n", per_cu); per_cu = 1; }
        (void)hipGetLastError();
        grid = cus * 1;
        if (grid <= 0) grid = 256;
    }
    Params p{};
    p.x = (const float*)d_in[0]; p.norm_gain = (const float*)d_in[1]; p.w_in = (const float*)d_in[2]; p.w_pool = (const float*)d_in[3];
    p.b_pool = (const float*)d_in[4]; p.pool_scale = (const float*)d_in[5]; p.w_out = (const float*)d_in[6]; p.final_gain = (const float*)d_in[7];
    p.out = (float*)d_out; p.ws = (unsigned char*)d_ws;
    if (hipMemsetAsync((char*)d_ws + WS_BAR, 0, XCD_BAR_WORDS * 4, stream) != hipSuccess) fprintf(stderr, "kernel_launch: memset of the barrier words failed\n");
    if (N_LAUNCHES == 1) {
        p.ph_lo = 0; p.ph_hi = 7;
        void* args[] = {&p};
        const hipError_t e = hipLaunchCooperativeKernel((const void*)hymba_fwd, dim3(grid), dim3(512), args, LDS_BYTES, stream);
        if (e != hipSuccess) fprintf(stderr, "kernel_launch: cooperative launch failed: %s (grid %d)\n", hipGetErrorString(e), grid);
    } else {
        for (int ph = 0; ph < 7; ++ph) { p.ph_lo = ph; p.ph_hi = ph + 1; hipLaunchKernelGGL(hymba_fwd, dim3(grid), dim3(512), LDS_BYTES, stream, p); }
    }
}
```
